# Optimizing an MI355X kernel written in HIP

```python
import math
import jax, jax.numpy as jnp
from jax import lax
import numpy as np


D_MODEL = 2048
BATCH = 1
SEQ = 8192
DEPTH = 4

N_MIXERS = 4
N_REPEAT = max(DEPTH // N_MIXERS, 1)
BLK = 128
NEG = -1e30
EPS = 1e-6
F32 = jnp.float32

REL_BUCKETS = 32
REL_MAX_DIST = 2048
REL_HEADS = 32

MLA_HEADS = 16
MLA_Q_RANK = 512
MLA_KV_RANK = 512
MLA_NOPE = 128
MLA_ROPE = 64
MLA_V = 128
ROPE_THETA = 10000.0

SWA_Q_HEADS = 32
SWA_KV_HEADS = 4
SWA_HEAD_DIM = 64
SWA_WINDOW = 128

DIL_HEADS = 32
DIL_HEAD_DIM = 64
DIL_PAIRS = ((128, 1), (512, 4), (2048, 16))

FOX_HEADS = 16
FOX_HEAD_DIM = 128

D_FF = 5632
CONV_WIDTH = 3

kernel_name = 'hybrid_interleaved_mla_swa_dilated_fox'


def _rmsnorm(x, g):
    xf = x.astype(F32)
    y = xf * lax.rsqrt(jnp.mean(xf * xf, axis=-1, keepdims=True) + EPS)
    return (y * g.astype(F32)).astype(x.dtype)


def _rope(x, positions):
    half = x.shape[-1] // 2
    inv_freq = ROPE_THETA ** (-jnp.arange(half, dtype=F32) / half)
    ang = positions.astype(F32)[:, :, None] * inv_freq
    ang = ang.reshape(ang.shape[:2] + (1,) * (x.ndim - 3) + (half,))
    cos, sin = jnp.cos(ang), jnp.sin(ang)
    x1 = x[..., :half].astype(F32)
    x2 = x[..., half:].astype(F32)
    return jnp.concatenate([x1 * cos - x2 * sin, x2 * cos + x1 * sin], axis=-1).astype(x.dtype)


def _t5_bucket(n):
    exact = REL_BUCKETS // 2
    nf = jnp.maximum(n, 1).astype(F32)
    large = exact + (jnp.log(nf / exact) / math.log(REL_MAX_DIST / exact) * (REL_BUCKETS - exact)).astype(jnp.int32)
    return jnp.where(n < exact, n, jnp.minimum(large, REL_BUCKETS - 1))


def _banded_stats(q, k, v, bias, max_dist):
    n, L, hk, g, dh = q.shape
    nb = L // BLK
    qb = q.reshape(n, nb, BLK, hk, g, dh)

    def band(a):
        ab = a.reshape(n, nb, BLK, hk, dh)
        prev = jnp.pad(ab, ((0, 0), (1, 0), (0, 0), (0, 0), (0, 0)))[:, :-1]
        return jnp.concatenate([prev, ab], axis=2)

    kb, vb = band(k), band(v)
    s = jnp.einsum('nbqhgd,nbkhd->nbhgqk', qb, kb, preferred_element_type=F32)
    qi = jnp.arange(BLK)[:, None]
    kj = jnp.arange(2 * BLK)[None, :]
    dist = qi + BLK - kj
    in_seq = jnp.arange(nb)[:, None, None] * BLK + kj - BLK >= 0
    valid = (dist >= 0) & (dist <= max_dist) & in_seq
    b = bias.astype(F32)[:, :, jnp.clip(dist, 0, max_dist)]
    s = jnp.where(valid[None, :, None, None], s + b, NEG)
    m = jnp.max(s, axis=-1)
    p = jnp.exp(s - m[..., None])
    l = jnp.sum(p, axis=-1)
    acc = jnp.einsum('nbhgqk,nbkhd->nbqhgd', p.astype(v.dtype), vb, preferred_element_type=F32)
    to_seq = lambda a: jnp.moveaxis(a, -1, 2).reshape(n, L, hk, g)
    return to_seq(m), to_seq(l), acc.reshape(n, L, hk, g, dh)


def _mla(h, positions, w_in, g_q, g_kv, w_qb, w_kvb, w_o):
    bsz, t, _ = h.shape
    qk_dim = MLA_NOPE + MLA_ROPE
    lat = h @ w_in
    c_q = _rmsnorm(lat[..., :MLA_Q_RANK], g_q)
    c_kv = _rmsnorm(lat[..., MLA_Q_RANK:MLA_Q_RANK + MLA_KV_RANK], g_kv)
    k_rope = _rope(lat[..., MLA_Q_RANK + MLA_KV_RANK:], positions)
    q = (c_q @ w_qb).reshape(bsz, t, MLA_HEADS, qk_dim) * qk_dim ** -0.5
    q_nope = q[..., :MLA_NOPE]
    q_rope = _rope(q[..., MLA_NOPE:], positions)
    kv = (c_kv @ w_kvb).reshape(bsz, t, MLA_HEADS, MLA_NOPE + MLA_V)
    k_nope, v = kv[..., :MLA_NOPE], kv[..., MLA_NOPE:]
    nb = t // BLK
    blocks = lambda a: a.reshape((bsz, nb, BLK) + a.shape[2:]).swapaxes(0, 1)
    kpos = jnp.arange(t)

    def block(args):
        qn, qr, i = args
        s = (jnp.einsum('bqhd,bkhd->bhqk', qn, k_nope, preferred_element_type=F32)
             + jnp.einsum('bqhd,bkd->bhqk', qr, k_rope, preferred_element_type=F32))
        qpos = i * BLK + jnp.arange(BLK)
        s = jnp.where(kpos[None, :] <= qpos[:, None], s, NEG)
        p = jax.nn.softmax(s, axis=-1)
        return jnp.einsum('bhqk,bkhd->bqhd', p.astype(v.dtype), v, preferred_element_type=F32)

    o = lax.map(block, (blocks(q_nope), blocks(q_rope), jnp.arange(nb)))
    o = o.swapaxes(0, 1).reshape(bsz, t, MLA_HEADS * MLA_V).astype(h.dtype)
    return o @ w_o


def _swa_sinks(h, rel_bias, w_qkv, b_qkv, sinks, w_o, b_o):
    bsz, t, _ = h.shape
    grp = SWA_Q_HEADS // SWA_KV_HEADS
    nq = SWA_Q_HEADS * SWA_HEAD_DIM
    nk = SWA_KV_HEADS * SWA_HEAD_DIM
    qkv = h @ w_qkv + b_qkv
    q = qkv[..., :nq].reshape(bsz, t, SWA_KV_HEADS, grp, SWA_HEAD_DIM) * SWA_HEAD_DIM ** -0.5
    k = qkv[..., nq:nq + nk].reshape(bsz, t, SWA_KV_HEADS, SWA_HEAD_DIM)
    v = qkv[..., nq + nk:].reshape(bsz, t, SWA_KV_HEADS, SWA_HEAD_DIM)
    bias = rel_bias[_t5_bucket(jnp.arange(SWA_WINDOW))].T.reshape(SWA_KV_HEADS, grp, SWA_WINDOW)
    m, l, acc = _banded_stats(q, k, v, bias, SWA_WINDOW - 1)
    sink = sinks.astype(F32).reshape(SWA_KV_HEADS, grp)
    m2 = jnp.maximum(m, sink)
    a = jnp.exp(m - m2)
    den = l * a + jnp.exp(sink - m2)
    o = acc * (a / den)[..., None]
    return o.reshape(bsz, t, nq).astype(h.dtype) @ w_o + b_o


def _dilated_attention(h, rel_bias, w_qkv, w_o):
    bsz, t, _ = h.shape
    q, k, v = jnp.split(h @ w_qkv, 3, axis=-1)
    q = q.reshape(bsz, t, DIL_HEADS, 1, DIL_HEAD_DIM) * DIL_HEAD_DIM ** -0.5
    k = k.reshape(bsz, t, DIL_HEADS, DIL_HEAD_DIM)
    v = v.reshape(bsz, t, DIL_HEADS, DIL_HEAD_DIM)
    ms, ls, accs = [], [], []
    for window, rate in DIL_PAIRS:
        n_keys = window // rate
        ts = t // rate
        lp = -(-ts // BLK) * BLK

        def to_sub(a):
            a = a.reshape((bsz, ts, rate) + a.shape[2:]).swapaxes(1, 2).reshape((bsz * rate, ts) + a.shape[2:])
            return jnp.pad(a, ((0, 0), (0, lp - ts)) + ((0, 0),) * (a.ndim - 2))

        def from_sub(a):
            a = a[:, :ts]
            return a.reshape((bsz, rate, ts) + a.shape[2:]).swapaxes(1, 2).reshape((bsz, t) + a.shape[2:])

        bias = rel_bias[_t5_bucket(rate * jnp.arange(n_keys + 1))].T[:, None, :]
        m, l, acc = _banded_stats(to_sub(q), to_sub(k), to_sub(v), bias, n_keys)
        ms.append(from_sub(m))
        ls.append(from_sub(l))
        accs.append(from_sub(acc))
    m = jnp.stack(ms)
    l = jnp.stack(ls)
    acc = jnp.stack(accs)
    wgt = jnp.exp(m - jnp.max(m, axis=0))
    o = jnp.sum(acc * wgt[..., None], axis=0) / jnp.sum(l * wgt, axis=0)[..., None]
    return o.reshape(bsz, t, DIL_HEADS * DIL_HEAD_DIM).astype(h.dtype) @ w_o


def _forgetting_attention(h, w_in, b_f, w_o):
    bsz, t, _ = h.shape
    hd = FOX_HEADS * FOX_HEAD_DIM
    proj = h @ w_in
    q = proj[..., :hd].reshape(bsz, t, FOX_HEADS, FOX_HEAD_DIM) * FOX_HEAD_DIM ** -0.5
    k = proj[..., hd:2 * hd].reshape(bsz, t, FOX_HEADS, FOX_HEAD_DIM)
    v = proj[..., 2 * hd:3 * hd].reshape(bsz, t, FOX_HEADS, FOX_HEAD_DIM)
    log_f = jax.nn.log_sigmoid(proj[..., 3 * hd:].astype(F32) + b_f.astype(F32))
    cum = jnp.cumsum(log_f, axis=1).transpose(0, 2, 1)
    nb = t // BLK
    q_blocks = q.reshape(bsz, nb, BLK, FOX_HEADS, FOX_HEAD_DIM).swapaxes(0, 1)
    c_blocks = cum.reshape(bsz, FOX_HEADS, nb, BLK).transpose(2, 0, 1, 3)
    kpos = jnp.arange(t)

    def block(args):
        qb, cb, i = args
        s = jnp.einsum('bqhd,bkhd->bhqk', qb, k, preferred_element_type=F32)
        s = s + cb[..., None] - cum[:, :, None, :]
        qpos = i * BLK + jnp.arange(BLK)
        s = jnp.where(kpos[None, :] <= qpos[:, None], s, NEG)
        p = jax.nn.softmax(s, axis=-1)
        return jnp.einsum('bhqk,bkhd->bqhd', p.astype(v.dtype), v, preferred_element_type=F32)

    o = lax.map(block, (q_blocks, c_blocks, jnp.arange(nb)))
    o = o.swapaxes(0, 1).reshape(bsz, t, hd).astype(h.dtype)
    return o @ w_o


def _conv_ffn(h, w_in, conv_w, conv_b, w_out):
    t = h.shape[1]
    u = h @ w_in
    up = jnp.pad(u, ((0, 0), (CONV_WIDTH - 1, 0), (0, 0)))
    c = conv_b + up[:, 0:t] * conv_w[0]
    for j in range(1, CONV_WIDTH):
        c = c + up[:, j:j + t] * conv_w[j]
    gate, val = jnp.split(c, 2, axis=-1)
    return (jax.nn.silu(gate) * val) @ w_out


def setup_inputs(seed: int = 0) -> dict:
    key = jax.random.key(seed)
    ks = iter(jax.random.split(key, 32))
    R, D = N_REPEAT, D_MODEL

    def w(shape, fan_in):
        return jax.random.normal(next(ks), shape, F32) * fan_in ** -0.5

    def gain(shape):
        return 1.0 + 0.02 * jax.random.normal(next(ks), shape, F32)

    def small(shape, scale):
        return scale * jax.random.normal(next(ks), shape, F32)

    x = jax.random.normal(next(ks), (BATCH, SEQ, D), F32)
    offset = jax.random.randint(next(ks), (BATCH, 1), 0, 1024, dtype=jnp.int32)
    positions = offset + jnp.arange(SEQ, dtype=jnp.int32)[None, :]
    swa_qkv = (SWA_Q_HEADS + 2 * SWA_KV_HEADS) * SWA_HEAD_DIM
    return {
        'x': x,
        'positions': positions,
        'rel_bias': small((REL_BUCKETS, REL_HEADS), 0.3),
        'norm_mix': gain((DEPTH, D)),
        'norm_ffn': gain((DEPTH, D)),
        'mla_w_in': w((R, D, MLA_Q_RANK + MLA_KV_RANK + MLA_ROPE), D),
        'mla_g_q': gain((R, MLA_Q_RANK)),
        'mla_g_kv': gain((R, MLA_KV_RANK)),
        'mla_w_qb': w((R, MLA_Q_RANK, MLA_HEADS * (MLA_NOPE + MLA_ROPE)), MLA_Q_RANK),
        'mla_w_kvb': w((R, MLA_KV_RANK, MLA_HEADS * (MLA_NOPE + MLA_V)), MLA_KV_RANK),
        'mla_w_o': w((R, MLA_HEADS * MLA_V, D), MLA_HEADS * MLA_V),
        'swa_w_qkv': w((R, D, swa_qkv), D),
        'swa_b_qkv': small((R, swa_qkv), 0.02),
        'swa_sinks': small((R, SWA_Q_HEADS), 0.5),
        'swa_w_o': w((R, SWA_Q_HEADS * SWA_HEAD_DIM, D), SWA_Q_HEADS * SWA_HEAD_DIM),
        'swa_b_o': small((R, D), 0.02),
        'dil_w_qkv': w((R, D, 3 * DIL_HEADS * DIL_HEAD_DIM), D),
        'dil_w_o': w((R, DIL_HEADS * DIL_HEAD_DIM, D), DIL_HEADS * DIL_HEAD_DIM),
        'fox_w_in': w((R, D, 3 * FOX_HEADS * FOX_HEAD_DIM + FOX_HEADS), D),
        'fox_b_f': 2.0 + small((R, FOX_HEADS), 0.5),
        'fox_w_o': w((R, FOX_HEADS * FOX_HEAD_DIM, D), FOX_HEADS * FOX_HEAD_DIM),
        'ffn_w_in': w((DEPTH, D, 2 * D_FF), D),
        'ffn_conv_w': w((DEPTH, CONV_WIDTH, 2 * D_FF), CONV_WIDTH),
        'ffn_conv_b': small((DEPTH, 2 * D_FF), 0.01),
        'ffn_w_out': w((DEPTH, D_FF, D), D_FF),
        'final_norm': gain((D,)),
    }


def reference(x, positions, rel_bias, norm_mix, norm_ffn,
              mla_w_in, mla_g_q, mla_g_kv, mla_w_qb, mla_w_kvb, mla_w_o,
              swa_w_qkv, swa_b_qkv, swa_sinks, swa_w_o, swa_b_o,
              dil_w_qkv, dil_w_o,
              fox_w_in, fox_b_f, fox_w_o,
              ffn_w_in, ffn_conv_w, ffn_conv_b, ffn_w_out,
              final_norm):
    h = x
    for i in range(DEPTH):
        kind = i % N_MIXERS
        r = i // N_MIXERS
        a = _rmsnorm(h, norm_mix[i])
        if kind == 0:
            y = _mla(a, positions, mla_w_in[r], mla_g_q[r], mla_g_kv[r], mla_w_qb[r], mla_w_kvb[r], mla_w_o[r])
        elif kind == 1:
            y = _swa_sinks(a, rel_bias, swa_w_qkv[r], swa_b_qkv[r], swa_sinks[r], swa_w_o[r], swa_b_o[r])
        elif kind == 2:
            y = _dilated_attention(a, rel_bias, dil_w_qkv[r], dil_w_o[r])
        else:
            y = _forgetting_attention(a, fox_w_in[r], fox_b_f[r], fox_w_o[r])
        h = h + y
        h = h + _conv_ffn(_rmsnorm(h, norm_ffn[i]), ffn_w_in[i], ffn_conv_w[i], ffn_conv_b[i], ffn_w_out[i])
    return _rmsnorm(h, final_norm)
```

```cpp
#include <hip/hip_runtime.h>
#include <hip/hip_cooperative_groups.h>
#include <cstdio>
#include <cstdint>
namespace cg = cooperative_groups;

#define LAS __attribute__((address_space(3)))
typedef unsigned short bf16_t;

__device__ __forceinline__ int ltid() { int t = threadIdx.x; asm volatile("" : "+v"(t)); return t; }
namespace pg8 {
#define PG8_LAS __attribute__((address_space(3)))
typedef short bf16x8 __attribute__((ext_vector_type(8)));
typedef float f32x4 __attribute__((ext_vector_type(4)));
typedef unsigned u32x4 __attribute__((ext_vector_type(4)));
constexpr int BM = 256, BK = 64, HALF = 128, HTB = HALF * BK * 2, STAGE_BYTES = 8 * HTB, NXCD = 8, WGM = 4;

__host__ __device__ __forceinline__ int lds_byte(int r, int c) { const int st = (r >> 4) * 2 + (c >> 5), rr = r & 15, cc = c & 31, ob = rr * 64 + cc * 2; return st * 1024 + (ob ^ (((ob >> 9) & 1) << 5)); }
__host__ __device__ __forceinline__ void stage_rc(int b, int& R, int& C) { const int st = b / 1024, sb = b % 1024, swz = sb ^ (((sb >> 9) & 1) << 5); R = (st >> 1) * 16 + swz / 64; C = (st & 1) * 32 + (swz % 64) / 2; }
__host__ __device__ __forceinline__ int perm32(int rho) { const int n = rho >> 4, i = rho & 15; return 8 * (i >> 2) + 4 * n + (i & 3); }

struct Unit { int pm, pn; };
struct Gemm { const bf16_t* A; const bf16_t* Bt; int M, N, K; int amode; };

struct StaticOrder {
    int nM, nN, nwg, G, c;
    __host__ __device__ void init(int M, int N, int G_, int c_) { nM = M / BM; nN = N / BM; nwg = nM * nN; G = G_; c = c_; }
    __host__ __device__ bool next(int i, Unit& u) const {
        const long L = (long)i * G + c; if (L >= nwg) return false;
        int wgid = (int)L; { const int q = nwg / NXCD, r = nwg % NXCD, xcd = wgid % NXCD, off = wgid / NXCD; wgid = (xcd < r ? xcd * (q + 1) : r * (q + 1) + (xcd - r) * q) + off; }
        const int nig = WGM * nN, gid = wgid / nig, fm = gid * WGM, gsz = (nM - fm) < WGM ? (nM - fm) : WGM;
        u.pm = fm + ((wgid % nig) % gsz); u.pn = (wgid % nig) / gsz; return true;
    }
    __device__ __forceinline__ void a_ready(const Unit&) const {}
    __device__ __forceinline__ void done(const Unit&) const {}
};

__device__ __forceinline__ unsigned cvt_pk_bf16(float lo, float hi) { unsigned r; asm volatile("v_cvt_pk_bf16_f32 %0, %1, %2" : "=v"(r) : "v"(lo), "v"(hi)); return r; }

__device__ __forceinline__ float row_ss(const float* part, int row, int fq, int nf4) {
    const f32x4* p = (const f32x4*)(part + (size_t)row * 32);
    float s = 0.f;
#pragma unroll
    for (int j = 0; j < 2; ++j) { const int idx = fq + 4 * j; if (idx < nf4) { const f32x4 v = p[idx]; s += (v[0] + v[1]) + (v[2] + v[3]); } }
    s += __shfl_xor(s, 16); s += __shfl_xor(s, 32);
    return s;
}
struct EpiBf16 {
    static constexpr bool PERM = true, AFTER_DRAIN = false;
    bf16_t* O; int ldc; const float* bias; int split_cols; size_t split_stride; float scale0; const float* rss; float rinv; int nf4;
    __device__ __forceinline__ void operator()(const f32x4 (&acc)[2][2][4][2], const Unit& u, int wr, int wc, int fr, int fq) const {
        const int row0 = u.pm * BM + wr * 64 + fr; int colt = u.pn * BM; bf16_t* base = O;
        float sc = 1.f; if (split_cols) { const int t = colt / split_cols; base += (size_t)t * split_stride; colt -= t * split_cols; if (t == 0) sc = scale0; } else sc = scale0;
        const int col0 = colt + wc * 32 + 8 * fq, bcol0 = u.pn * BM + wc * 32 + 8 * fq;
        f32x4 bv[2][2];
#pragma unroll
        for (int bj = 0; bj < 2; ++bj)
#pragma unroll
            for (int n = 0; n < 2; ++n) bv[bj][n] = bias ? *(const f32x4*)(bias + bcol0 + bj * HALF + 4 * n) : (f32x4){0.f, 0.f, 0.f, 0.f};
#pragma unroll
        for (int ai = 0; ai < 2; ++ai)
#pragma unroll
            for (int m = 0; m < 4; ++m) { const int row = row0 + ai * HALF + m * 16; bf16_t* rowp = base + (size_t)row * ldc + col0;
                const float rs = rss ? __builtin_amdgcn_rsqf(row_ss(rss, row, fq, nf4) * rinv + 1e-6f) : 1.f;
#pragma unroll
                for (int bj = 0; bj < 2; ++bj) { f32x4 v0 = acc[ai][bj][m][0] * rs + bv[bj][0], v1 = acc[ai][bj][m][1] * rs + bv[bj][1];
                    v0 = v0 * sc; v1 = v1 * sc; u32x4 w; w.x = cvt_pk_bf16(v0[0], v0[1]); w.y = cvt_pk_bf16(v0[2], v0[3]); w.z = cvt_pk_bf16(v1[0], v1[1]); w.w = cvt_pk_bf16(v1[2], v1[3]);
                    *(u32x4*)(rowp + bj * HALF) = w; } }
    }
};
template <bool RESID> struct EpiF32 {
    static constexpr bool PERM = false, AFTER_DRAIN = false;
    float* H; int ldc; const float* bias; bf16_t* HB; float* ssout; const float* rss; size_t grp_stride; float accs;
    __device__ __forceinline__ void operator()(const f32x4 (&acc)[2][2][4][2], const Unit& u, int wr, int wc, int fr, int fq) const {
        typedef unsigned u32x2_t __attribute__((ext_vector_type(2)));
        const int row0 = u.pm * BM + wr * 64 + fr, col0 = (RESID ? u.pn * BM : (u.pn & 1) * BM) + wc * 32 + 4 * fq;
        bf16_t* hb = HB + (RESID ? (size_t)0 : (size_t)(u.pn >> 1) * grp_stride);
        f32x4 bv[2][2];
#pragma unroll
        for (int bj = 0; bj < 2; ++bj)
#pragma unroll
            for (int n = 0; n < 2; ++n) bv[bj][n] = (RESID && bias) ? *(const f32x4*)(bias + col0 + bj * HALF + 16 * n) : (f32x4){0.f, 0.f, 0.f, 0.f};
        float* ssp = ssout + (RESID ? (size_t)(u.pn * 4 + wc) : (size_t)8192 * 32 * (u.pn >> 1) + (u.pn & 1) * 4 + wc);
#pragma unroll
        for (int ai = 0; ai < 2; ++ai)
#pragma unroll
            for (int m = 0; m < 4; ++m) { const int row = row0 + ai * HALF + m * 16; const size_t roff = (size_t)row * ldc + col0;
                const float rs = (!RESID && rss) ? __builtin_amdgcn_rsqf(row_ss(rss, row, fq, 8) * (1.f / 2048.f) + 1e-6f) : 1.f;
                float ss = 0.f;
#pragma unroll
                for (int bj = 0; bj < 2; ++bj)
#pragma unroll
                    for (int n = 0; n < 2; ++n) { f32x4 v;
                        if (RESID) { f32x4* p = (f32x4*)(H + roff + bj * HALF + 16 * n); v = (acc[ai][bj][m][n] + bv[bj][n]) * accs + *p; *p = v; }
                        else v = acc[ai][bj][m][n] * rs;
                        ss += (v[0] * v[0] + v[1] * v[1]) + (v[2] * v[2] + v[3] * v[3]);
                        u32x2_t w; w.x = cvt_pk_bf16(v[0], v[1]); w.y = cvt_pk_bf16(v[2], v[3]);
                        *(u32x2_t*)(hb + roff + bj * HALF + 16 * n) = w; }
                ss += __shfl_xor(ss, 16); ss += __shfl_xor(ss, 32);
                if (fq == 0) ssp[(size_t)row * 32] = ss;
                if (m & 1) asm volatile("" ::: "memory"); }
    }
};

struct EpiRes {
    static constexpr bool PERM = true, AFTER_DRAIN = false;
    bf16_t* HB; int ldc; const float* bias; float* ssout; float accs;
    __device__ __forceinline__ void operator()(const f32x4 (&acc)[2][2][4][2], const Unit& u, int wr, int wc, int fr, int fq) const {
        const int row0 = u.pm * BM + wr * 64 + fr, col0 = u.pn * BM + wc * 32 + 8 * fq;
        f32x4 bv[2][2];
#pragma unroll
        for (int bj = 0; bj < 2; ++bj)
#pragma unroll
            for (int n = 0; n < 2; ++n) bv[bj][n] = bias ? *(const f32x4*)(bias + col0 + bj * HALF + 4 * n) : (f32x4){0.f, 0.f, 0.f, 0.f};
        float* ssp = ssout + (size_t)(u.pn * 4 + wc);
#pragma unroll
        for (int ai = 0; ai < 2; ++ai) {
            u32x4 old[4][2];
#pragma unroll
            for (int m = 0; m < 4; ++m)
#pragma unroll
                for (int bj = 0; bj < 2; ++bj) old[m][bj] = *(const u32x4*)(HB + (size_t)(row0 + ai * HALF + m * 16) * ldc + col0 + bj * HALF);
#pragma unroll
            for (int m = 0; m < 4; ++m) { const int row = row0 + ai * HALF + m * 16; float ss = 0.f;
#pragma unroll
                for (int bj = 0; bj < 2; ++bj) { const u32x4 ow = old[m][bj];
                    f32x4 v0 = (acc[ai][bj][m][0] + bv[bj][0]) * accs, v1 = (acc[ai][bj][m][1] + bv[bj][1]) * accs;
                    v0[0] += __uint_as_float(ow.x << 16); v0[1] += __uint_as_float(ow.x & 0xffff0000u); v0[2] += __uint_as_float(ow.y << 16); v0[3] += __uint_as_float(ow.y & 0xffff0000u);
                    v1[0] += __uint_as_float(ow.z << 16); v1[1] += __uint_as_float(ow.z & 0xffff0000u); v1[2] += __uint_as_float(ow.w << 16); v1[3] += __uint_as_float(ow.w & 0xffff0000u);
                    ss += (v0[0] * v0[0] + v0[1] * v0[1]) + (v0[2] * v0[2] + v0[3] * v0[3]) + (v1[0] * v1[0] + v1[1] * v1[1]) + (v1[2] * v1[2] + v1[3] * v1[3]);
                    u32x4 w; w.x = cvt_pk_bf16(v0[0], v0[1]); w.y = cvt_pk_bf16(v0[2], v0[3]); w.z = cvt_pk_bf16(v1[0], v1[1]); w.w = cvt_pk_bf16(v1[2], v1[3]);
                    *(u32x4*)(HB + (size_t)row * ldc + col0 + bj * HALF) = w; }
                ss += __shfl_xor(ss, 16); ss += __shfl_xor(ss, 32);
                if (fq == 0) ssp[(size_t)row * 32] = ss; }
            asm volatile("" ::: "memory");
        }
    }
};

__device__ __forceinline__ float dpp_up1(float x) { return __builtin_bit_cast(float, __builtin_amdgcn_update_dpp(0, __builtin_bit_cast(int, x), 0x111, 0xf, 0xf, true)); }
struct EpiConv {
    static constexpr bool PERM = true, AFTER_DRAIN = false;
    bf16_t* G; const float* cw; const float* cb; const float* rss;
    __device__ __forceinline__ void operator()(const f32x4 (&acc)[2][2][4][2], const Unit& u, int wr, int wc, int fr, int fq) const {
        typedef unsigned u32x2_t __attribute__((ext_vector_type(2)));
        constexpr int DFF_ = 5632, TT = 8192;
        u32x2_t stash[2][4];
        const bool edge = (u.pm == 0) || (248 * u.pm + 248 > TT);
        float rs[2][4];
#pragma unroll
        for (int ai = 0; ai < 2; ++ai)
#pragma unroll
            for (int m = 0; m < 4; ++m) { const int g = 248 * u.pm + 62 * (2 * ai + wr) - 2 + 4 * fr + m; const bool ok = g >= 0 && g < TT;
                const float ss = row_ss(rss, ok ? g : 0, fq, 8);
                rs[ai][m] = ok ? __builtin_amdgcn_rsqf(ss * (1.f / 2048.f) + 1e-6f) : 0.f; }
#pragma unroll
        for (int n = 0; n < 2; ++n) {
            const int f0 = u.pn * 128 + wc * 32 + 8 * fq + 4 * n;
            const f32x4 w0g = *(const f32x4*)(cw + f0) * 1.4426950408889634f, w1g = *(const f32x4*)(cw + 2 * DFF_ + f0) * 1.4426950408889634f, w2g = *(const f32x4*)(cw + 4 * DFF_ + f0) * 1.4426950408889634f, bg = *(const f32x4*)(cb + f0) * 1.4426950408889634f;
            const f32x4 w0v = *(const f32x4*)(cw + DFF_ + f0) * 0.6931471805599453f, w1v = *(const f32x4*)(cw + 3 * DFF_ + f0) * 0.6931471805599453f, w2v = *(const f32x4*)(cw + 5 * DFF_ + f0) * 0.6931471805599453f, bv = *(const f32x4*)(cb + DFF_ + f0) * 0.6931471805599453f;
#pragma unroll
            for (int ai = 0; ai < 2; ++ai) {
                const int g0 = 248 * u.pm + 62 * (2 * ai + wr) - 2 + 4 * fr;
                f32x4 xg[4], xv[4];
#pragma unroll
                for (int m = 0; m < 4; ++m) { const float r = rs[ai][m];
#pragma unroll
                    for (int e = 0; e < 4; ++e) { xg[m][e] = acc[ai][0][m][n][e] * r; xv[m][e] = acc[ai][1][m][n][e] * r; } }
                if (edge) {
#pragma unroll
                    for (int m = 0; m < 4; ++m) { const bool z = rs[ai][m] == 0.f;
#pragma unroll
                        for (int e = 0; e < 4; ++e) { xg[m][e] = z ? 0.f : xg[m][e]; xv[m][e] = z ? 0.f : xv[m][e]; } }
                }
                f32x4 pg2, pg3, pv2, pv3;
#pragma unroll
                for (int e = 0; e < 4; ++e) { pg2[e] = dpp_up1(xg[2][e]); pg3[e] = dpp_up1(xg[3][e]); pv2[e] = dpp_up1(xv[2][e]); pv3[e] = dpp_up1(xv[3][e]); }
#pragma unroll
                for (int m = 0; m < 4; ++m) {
                    u32x2_t w; float o[4];
#pragma unroll
                    for (int e = 0; e < 4; ++e) {
                        const float g1 = m >= 1 ? xg[m - (m >= 1 ? 1 : 0)][e] : pg3[e], g2 = m >= 2 ? xg[m - (m >= 2 ? 2 : 0)][e] : (m == 1 ? pg3[e] : pg2[e]);
                        const float v1 = m >= 1 ? xv[m - (m >= 1 ? 1 : 0)][e] : pv3[e], v2 = m >= 2 ? xv[m - (m >= 2 ? 2 : 0)][e] : (m == 1 ? pv3[e] : pv2[e]);
                        const float cg_ = bg[e] + w0g[e] * g2 + w1g[e] * g1 + w2g[e] * xg[m][e];
                        const float cv_ = bv[e] + w0v[e] * v2 + w1v[e] * v1 + w2v[e] * xv[m][e];
                        o[e] = cg_ * cv_ * __builtin_amdgcn_rcpf(1.0f + __builtin_amdgcn_exp2f(-cg_));
                    }
                    w.x = cvt_pk_bf16(o[0], o[1]); w.y = cvt_pk_bf16(o[2], o[3]);
                    const int g = g0 + m;
                    if (n == 0) stash[ai][m] = w;
                    else if ((fr > 0 || m >= 2) && g < TT) { u32x4 ww; ww.x = stash[ai][m].x; ww.y = stash[ai][m].y; ww.z = w.x; ww.w = w.y; *(u32x4*)(G + (size_t)g * DFF_ + f0 - 4) = ww; }
                }
            }
        }
    }
};

template <class Epi, class Sched, bool ALIGN_EPI = false, bool SP2 = false>
__device__ __forceinline__ void gemm_phase(PG8_LAS unsigned char* lds, const Gemm g, const Sched& S, const Epi& E) {
    const int tid = ltid(), wid = __builtin_amdgcn_readfirstlane(tid >> 6), lane = tid & 63, wr = wid >> 2, wc = wid & 3, fr = lane & 15, fq = lane >> 4;
    const int K = g.K, nt = K / BK;
    unsigned voffA[2], voffB[2];
#pragma unroll
    for (int i = 0; i < 2; ++i) { int R, C; stage_rc(tid * 16 + i * 8192, R, C); const int Rb = Epi::PERM ? ((R & ~31) + perm32(R & 31)) : R;
        const int Ra = g.amode ? (62 * (R >> 6) + 4 * (R & 15) + ((R >> 4) & 3)) : R;
        voffA[i] = (unsigned)(Ra * K + C) * 2u; voffB[i] = (unsigned)(Rb * K + C) * 2u; }
    const size_t kstep = (size_t)(BK * 2);
    const size_t hstep = (size_t)HALF * K * 2;
    const size_t tstep = 2 * hstep;
    const size_t hstepA = g.amode ? (size_t)124 * K * 2 : hstep, tstepA = 2 * hstepA;
    const char* Abase = (const char*)g.A - (g.amode ? (size_t)2 * K * 2 : (size_t)0);
    const unsigned ldsw = (unsigned)wid * 1024u;
    const int aoff = lds_byte(wr * 64 + fr, fq * 8), boff = lds_byte(wc * 32 + fr, fq * 8);
#define PG8_SA(b, h) (((b) * 2 + (h)) * HTB)
#define PG8_SB(b, h) ((4 + (b) * 2 + (h)) * HTB)
#define PG8_STAGE(bufoff, gbase, voff) do { _Pragma("unroll") for (int _i = 0; _i < 2; ++_i) \
        __builtin_amdgcn_global_load_lds((const unsigned*)((const char*)(gbase) + (voff)[_i]), (PG8_LAS unsigned*)(lds + (bufoff) + ldsw + _i * 8192), 16, 0, 0); } while (0)
#define PG8_LDA(dst, b, h) do { _Pragma("unroll") for (int m = 0; m < 4; ++m) _Pragma("unroll") for (int k = 0; k < 2; ++k) dst[m][k] = *(const PG8_LAS bf16x8*)(lds + PG8_SA(b, h) + aoff + m * 2048 + k * 1024); } while (0)
#define PG8_LDB(dst, b, h) do { _Pragma("unroll") for (int n = 0; n < 2; ++n) _Pragma("unroll") for (int k = 0; k < 2; ++k) dst[n][k] = *(const PG8_LAS bf16x8*)(lds + PG8_SB(b, h) + boff + n * 2048 + k * 1024); } while (0)
#define PG8_MMA(ai, bj, At, Bt) do { __builtin_amdgcn_s_setprio(1); _Pragma("unroll") for (int m = 0; m < 4; ++m) _Pragma("unroll") for (int n = 0; n < 2; ++n) _Pragma("unroll") for (int k = 0; k < 2; ++k) \
        acc[ai][bj][m][n] = __builtin_amdgcn_mfma_f32_16x16x32_bf16(Bt[n][k], At[m][k], acc[ai][bj][m][n], 0, 0, 0); __builtin_amdgcn_s_setprio(0); } while (0)
#define PG8_WAIT_V(n) asm volatile("s_waitcnt vmcnt(" #n ")" ::: "memory")
#define PG8_WAIT_L(n) asm volatile("s_waitcnt lgkmcnt(" #n ")" ::: "memory")
#define PG8_BAR __builtin_amdgcn_s_barrier()
#define PG8_SCHED __builtin_amdgcn_sched_barrier(0)
    Unit cur, nxt; int ui = 0;
    if (!S.next(0, cur)) return;
    f32x4 acc[2][2][4][2];
#pragma unroll
    for (int a = 0; a < 2; ++a)
#pragma unroll
        for (int b = 0; b < 2; ++b)
#pragma unroll
            for (int m = 0; m < 4; ++m)
#pragma unroll
                for (int n = 0; n < 2; ++n) acc[a][b][m][n] = (f32x4){0.f, 0.f, 0.f, 0.f};
    bf16x8 At[4][2], B0[2][2], B1[2][2];
    const char* cA = Abase + (size_t)cur.pm * tstepA; const char* cB = (const char*)g.Bt + (size_t)cur.pn * tstep;
    S.a_ready(cur);
    if constexpr (SP2) {
        PG8_STAGE(PG8_SB(0, 0), cB, voffB); PG8_STAGE(PG8_SB(0, 1), cB + hstep, voffB); PG8_STAGE(PG8_SA(0, 0), cA, voffA); PG8_STAGE(PG8_SA(0, 1), cA + hstepA, voffA);
        if (wr == 1) PG8_BAR;
        PG8_WAIT_V(2); PG8_BAR;
        PG8_STAGE(PG8_SB(1, 0), cB + kstep, voffB); PG8_STAGE(PG8_SA(1, 0), cA + kstep, voffA); PG8_STAGE(PG8_SB(1, 1), cB + hstep + kstep, voffB);
        PG8_WAIT_V(6); PG8_BAR;
    } else {
        PG8_STAGE(PG8_SB(0, 0), cB, voffB); PG8_STAGE(PG8_SA(0, 0), cA, voffA); PG8_STAGE(PG8_SB(0, 1), cB + hstep, voffB); PG8_STAGE(PG8_SA(0, 1), cA + hstepA, voffA);
        if (wr == 1) PG8_BAR;
        PG8_WAIT_V(4); PG8_BAR;
        PG8_STAGE(PG8_SB(1, 0), cB + kstep, voffB); PG8_STAGE(PG8_SA(1, 0), cA + kstep, voffA); PG8_STAGE(PG8_SB(1, 1), cB + hstep + kstep, voffB);
        PG8_WAIT_V(6); PG8_BAR;
    }
    for (;;) {
        const bool has_next = S.next(ui + 1, nxt);
        const char* nA = has_next ? Abase + (size_t)nxt.pm * tstepA : cA; const char* nB = has_next ? (const char*)g.Bt + (size_t)nxt.pn * tstep : cB;
        for (int t = 0; t < nt; t += 2) {
            const bool last = (t == nt - 2);
            const char* a1 = cA + (size_t)(t + 1) * kstep;
            const char* a2 = last ? nA : cA + (size_t)(t + 2) * kstep; const char* b2 = last ? nB : cB + (size_t)(t + 2) * kstep;
            const char* a3 = a2 + kstep; const char* b3 = b2 + kstep;
            if (last && has_next) S.a_ready(nxt);
            if constexpr (SP2) {
            PG8_LDB(B0, 0, 0); PG8_LDB(B1, 0, 1); PG8_SCHED; PG8_LDA(At, 0, 0); PG8_STAGE(PG8_SA(1, 1), a1 + hstepA, voffA);
            PG8_WAIT_V(8); PG8_WAIT_L(0); PG8_BAR; PG8_MMA(0, 0, At, B0); PG8_MMA(0, 1, At, B1); PG8_BAR; PG8_SCHED;
            PG8_LDA(At, 0, 1); PG8_STAGE(PG8_SB(0, 0), b2, voffB); PG8_STAGE(PG8_SB(0, 1), b2 + hstep, voffB); PG8_STAGE(PG8_SA(0, 0), a2, voffA);
            PG8_WAIT_V(8); PG8_WAIT_L(0); PG8_BAR; PG8_MMA(1, 0, At, B0); PG8_MMA(1, 1, At, B1); PG8_BAR; PG8_SCHED;
            PG8_LDB(B0, 1, 0); PG8_LDB(B1, 1, 1); PG8_SCHED; PG8_LDA(At, 1, 0); PG8_STAGE(PG8_SA(0, 1), a2 + hstepA, voffA);
            PG8_WAIT_V(8); PG8_WAIT_L(0); PG8_BAR; PG8_MMA(0, 0, At, B0); PG8_MMA(0, 1, At, B1); PG8_BAR; PG8_SCHED;
            PG8_LDA(At, 1, 1); PG8_STAGE(PG8_SB(1, 0), b3, voffB); PG8_STAGE(PG8_SB(1, 1), b3 + hstep, voffB); PG8_STAGE(PG8_SA(1, 0), a3, voffA);
            PG8_WAIT_V(8); PG8_WAIT_L(0); PG8_BAR; PG8_MMA(1, 0, At, B0); PG8_MMA(1, 1, At, B1); PG8_BAR; PG8_SCHED;
            } else {
            PG8_LDB(B0, 0, 0); PG8_SCHED; PG8_LDA(At, 0, 0); PG8_STAGE(PG8_SA(1, 1), a1 + hstepA, voffA);
            PG8_WAIT_L(8); PG8_BAR; PG8_WAIT_L(0); PG8_MMA(0, 0, At, B0); PG8_BAR; PG8_SCHED;
            PG8_LDB(B1, 0, 1); PG8_STAGE(PG8_SB(0, 0), b2, voffB);
            PG8_BAR; PG8_WAIT_L(0); PG8_MMA(0, 1, At, B1); PG8_BAR;
            PG8_LDA(At, 0, 1); PG8_STAGE(PG8_SA(0, 0), a2, voffA);
            PG8_BAR; PG8_WAIT_L(0); PG8_MMA(1, 0, At, B0); PG8_BAR; PG8_SCHED;
            PG8_STAGE(PG8_SB(0, 1), b2 + hstep, voffB);
            PG8_WAIT_V(6); PG8_BAR; PG8_MMA(1, 1, At, B1); PG8_BAR;
            PG8_LDB(B0, 1, 0); PG8_SCHED; PG8_LDA(At, 1, 0); PG8_STAGE(PG8_SA(0, 1), a2 + hstepA, voffA);
            PG8_WAIT_L(8); PG8_BAR; PG8_WAIT_L(0); PG8_MMA(0, 0, At, B0); PG8_BAR; PG8_SCHED;
            PG8_LDB(B1, 1, 1); PG8_STAGE(PG8_SB(1, 0), b3, voffB);
            PG8_BAR; PG8_WAIT_L(0); PG8_MMA(0, 1, At, B1); PG8_BAR;
            PG8_LDA(At, 1, 1); PG8_STAGE(PG8_SA(1, 0), a3, voffA);
            PG8_BAR; PG8_WAIT_L(0); PG8_MMA(1, 0, At, B0); PG8_BAR; PG8_SCHED;
            PG8_STAGE(PG8_SB(1, 1), b3 + hstep, voffB);
            PG8_WAIT_V(6); PG8_BAR; PG8_MMA(1, 1, At, B1); PG8_BAR;
            }
        }
        if constexpr (ALIGN_EPI) { if (wr == 0) PG8_BAR; }
        if constexpr (!Epi::AFTER_DRAIN) { E(acc, cur, wr, wc, fr, fq); S.done(cur); }
        if (!has_next) break;
#pragma unroll
        for (int a = 0; a < 2; ++a)
#pragma unroll
            for (int b = 0; b < 2; ++b)
#pragma unroll
                for (int m = 0; m < 4; ++m)
#pragma unroll
                    for (int n = 0; n < 2; ++n) acc[a][b][m][n] = (f32x4){0.f, 0.f, 0.f, 0.f};
        cur = nxt; cA = nA; cB = nB; ++ui;
        if constexpr (ALIGN_EPI) { if (wr == 1) PG8_BAR; }
    }
    PG8_WAIT_V(0);
    if constexpr (!ALIGN_EPI) { if (wr == 0) PG8_BAR; }
    PG8_BAR;
#undef PG8_SA
#undef PG8_SB
#undef PG8_STAGE
#undef PG8_LDA
#undef PG8_LDB
#undef PG8_MMA
#undef PG8_WAIT_V
#undef PG8_WAIT_L
#undef PG8_BAR
#undef PG8_SCHED
}
}

constexpr int T = 8192, D = 2048, DFF = 5632;
constexpr float EPS = 1e-6f;
constexpr float LOG2E = 1.4426950408889634f;
constexpr size_t MiB = 1u << 20;
constexpr size_t WS_W_MLA_IN = 0;
constexpr size_t WS_W_MLA_QB = WS_W_MLA_IN + 5 * MiB;
constexpr size_t WS_W_MLA_KVB = WS_W_MLA_QB + 3 * MiB;
constexpr size_t WS_W_MLA_O = WS_W_MLA_KVB + 4 * MiB;
constexpr size_t WS_W_SWA_QKV = WS_W_MLA_O + 8 * MiB;
constexpr size_t WS_W_SWA_O = WS_W_SWA_QKV + 10 * MiB;
constexpr size_t WS_W_DIL_QKV = WS_W_SWA_O + 8 * MiB;
constexpr size_t WS_W_DIL_O = WS_W_DIL_QKV + 24 * MiB;
constexpr size_t WS_W_FOX_IN = WS_W_DIL_O + 8 * MiB;
constexpr size_t WS_W_FOX_O = WS_W_FOX_IN + 25 * MiB;
constexpr size_t WS_W_FFN_IN = WS_W_FOX_O + 8 * MiB;
constexpr size_t WS_W_FFN_OUT = WS_W_FFN_IN + 176 * MiB;
constexpr size_t WS_H = WS_W_FFN_OUT + 88 * MiB;
constexpr size_t WS_XN = WS_H + 64 * MiB;
constexpr size_t WS_U = WS_XN + 32 * MiB;
constexpr size_t WS_G = WS_U + 176 * MiB;
constexpr size_t WS_Q = WS_G + 88 * MiB;
constexpr size_t QKV_STRIDE = 48 * MiB;
constexpr size_t WS_O = WS_Q + 4 * QKV_STRIDE;
constexpr size_t WS_LAT = WS_O + 32 * MiB;
constexpr size_t WS_CQ = WS_LAT + 40 * MiB;
constexpr size_t WS_CKV = WS_CQ + 8 * MiB;
constexpr size_t WS_KROPE = WS_CKV + 8 * MiB;
constexpr size_t WS_CUM = WS_KROPE + 1 * MiB;
constexpr size_t WS_ACC = WS_CUM + 1 * MiB;
constexpr size_t WS_MST = WS_ACC + 64 * MiB;
constexpr size_t WS_LST = WS_MST + 1 * MiB;
constexpr size_t WS_CTL = WS_LST + 1 * MiB;
constexpr size_t CTL_BYTES = 65536;
constexpr size_t WS_SS = WS_CTL + 1 * MiB;
constexpr size_t WS_END = WS_SS + 12 * MiB;

constexpr int LDS_BYTES = 131072 + 1024;

struct Params {
    const float* x; const int* pos; const float* rel_bias; const float* norm_mix; const float* norm_ffn;
    const float* mla_w_in; const float* mla_g_q; const float* mla_g_kv; const float* mla_w_qb; const float* mla_w_kvb; const float* mla_w_o;
    const float* swa_w_qkv; const float* swa_b_qkv; const float* swa_sinks; const float* swa_w_o; const float* swa_b_o;
    const float* dil_w_qkv; const float* dil_w_o;
    const float* fox_w_in; const float* fox_b_f; const float* fox_w_o;
    const float* ffn_w_in; const float* ffn_conv_w; const float* ffn_conv_b; const float* ffn_w_out;
    const float* final_norm;
    float* out; unsigned char* ws;
};

typedef short bf16x8 __attribute__((ext_vector_type(8)));
typedef short s16x4 __attribute__((ext_vector_type(4)));
typedef float f32x16 __attribute__((ext_vector_type(16)));
typedef float f32x4 __attribute__((ext_vector_type(4)));
typedef float f32x2 __attribute__((ext_vector_type(2)));
typedef unsigned u32x4 __attribute__((ext_vector_type(4)));
typedef unsigned u32x2 __attribute__((ext_vector_type(2)));
typedef __bf16 bf16x2_t __attribute__((ext_vector_type(2)));

__device__ __forceinline__ unsigned cvtpk(float lo, float hi) { f32x2 v = {lo, hi}; bf16x2_t b = __builtin_convertvector(v, bf16x2_t); return __builtin_bit_cast(unsigned, b); }
__device__ __forceinline__ float bf2f(unsigned short u) { return __uint_as_float((unsigned)u << 16); }
__device__ __forceinline__ float wave_sum(float v) {
#pragma unroll
    for (int o = 1; o < 64; o <<= 1) v += __shfl_xor(v, o);
    return v;
}
__device__ __forceinline__ float fexp2(float x) { return __builtin_amdgcn_exp2f(x); }

struct WItem { f32x4 v[8]; float g[8]; };
__device__ __forceinline__ void witem_load(WItem& w, const float* W, int N, const float* gk, int item, int nblk, int lane) {
    const int kb = item / nblk, nb = item % nblk, k0 = 64 * kb, n0 = 32 * nb;
    const int col = 4 * (lane & 7), rr = lane >> 3;
    const bool ok = (n0 + col) < N;
#pragma unroll
    for (int i = 0; i < 8; ++i) { w.v[i] = ok ? __builtin_nontemporal_load((const f32x4*)(W + (size_t)(k0 + 8 * i + rr) * N + n0 + col)) : (f32x4){0.f, 0.f, 0.f, 0.f};
        w.g[i] = gk ? gk[k0 + 8 * i + rr] : 1.f; }
}
__device__ __forceinline__ void witem_store(const WItem& w, int K, bf16_t* WT, int kvperm, LAS float* scr, int item, int nblk, int lane) {
    const int kb = item / nblk, nb = item % nblk, k0 = 64 * kb, n0 = 32 * nb;
    const int col = 4 * (lane & 7), rr = lane >> 3;
#pragma unroll
    for (int i = 0; i < 8; ++i) { LAS float* d = scr + (8 * i + rr) * 33 + col; const float g = w.g[i]; d[0] = w.v[i].x * g; d[1] = w.v[i].y * g; d[2] = w.v[i].z * g; d[3] = w.v[i].w * g; }
    asm volatile("s_waitcnt lgkmcnt(0)" ::: "memory");
    const int c = lane & 7;
#pragma unroll
    for (int j = 0; j < 4; ++j) { const int n = (lane >> 3) + 8 * j; const LAS float* s = scr + (8 * c) * 33 + n;
        u32x4 o; o.x = cvtpk(s[0 * 33], s[1 * 33]); o.y = cvtpk(s[2 * 33], s[3 * 33]); o.z = cvtpk(s[4 * 33], s[5 * 33]); o.w = cvtpk(s[6 * 33], s[7 * 33]);
        int nr = n0 + n; if (kvperm == 1) { const int hh = nr >> 8, ww = nr & 255; nr = (ww < 128) ? hh * 128 + ww : 2048 + hh * 128 + (ww - 128); }
        else if (kvperm == 2) { const int isv = nr >= 5632, f = isv ? nr - 5632 : nr; nr = (f >> 7) * 256 + isv * 128 + (f & 127); }
        *(u32x4*)(WT + (size_t)nr * K + k0 + 8 * c) = o; }
    asm volatile("s_waitcnt lgkmcnt(0)" ::: "memory");
}
struct WaveSlot { int gw, NGW, rot; };
__device__ __forceinline__ void convert_weight(const float* W, int K, int N, int Npad, bf16_t* WT, int kvperm, const float* gk, LAS float* scr, WaveSlot& ws, int lane, int pct0 = 0, int pct1 = 100) {
    const int nblk = Npad / 32, nitems = (K / 64) * nblk;
    const int i0 = (int)((long)nitems * pct0 / 100), i1 = (int)((long)nitems * pct1 / 100);
    const int NGW = ws.NGW;
    int gwr = ws.gw - ws.rot; if (gwr < 0) gwr += NGW;
    ws.rot = (ws.rot + (i1 - i0)) % NGW;
    int it = i0 + gwr;
    WItem cur, nxt;
    if (it < i1) witem_load(nxt, W, N, gk, it, nblk, lane);
    while (it < i1) {
        cur = nxt;
        const int nit = it + NGW;
        if (nit < i1) witem_load(nxt, W, N, gk, nit, nblk, lane);
        witem_store(cur, K, WT, kvperm, scr, it, nblk, lane);
        it = nit;
    }
}

__device__ __forceinline__ void p0_row(const float* xrow, bf16_t* hbrow, float* ss, int lane) {
    f32x4 v[8]; float s = 0.f;
#pragma unroll
    for (int j = 0; j < 8; ++j) { v[j] = *(const f32x4*)(xrow + 4 * lane + 256 * j); s += (v[j].x * v[j].x + v[j].y * v[j].y) + (v[j].z * v[j].z + v[j].w * v[j].w); }
    s = wave_sum(s);
    if (lane < 32) ss[lane] = lane == 0 ? s : 0.f;
#pragma unroll
    for (int j = 0; j < 8; ++j) {
        u32x2 w; w.x = cvtpk(v[j].x, v[j].y); w.y = cvtpk(v[j].z, v[j].w);
        *(u32x2*)(hbrow + 4 * lane + 256 * j) = w; }
}
__device__ __forceinline__ void final_row(const bf16_t* hrow, const float* gain, const float* ssrow, float* orow, int lane) {
    const float ss = wave_sum(lane < 32 ? ssrow[lane] : 0.f);
    const float r = 1.0f / sqrtf(ss * (1.f / D) + EPS);
#pragma unroll
    for (int j = 0; j < 8; ++j) { const u32x2 hw = *(const u32x2*)(hrow + 4 * lane + 256 * j); const f32x4 g = *(const f32x4*)(gain + 4 * lane + 256 * j);
        f32x4 o; o.x = __uint_as_float(hw.x << 16) * r * g.x; o.y = __uint_as_float(hw.x & 0xffff0000u) * r * g.y; o.z = __uint_as_float(hw.y << 16) * r * g.z; o.w = __uint_as_float(hw.y & 0xffff0000u) * r * g.w;
        *(f32x4*)(orow + 4 * lane + 256 * j) = o; }
}

__device__ const double ROPE_INV[32] = {
1.0, 0.7498942093324559, 0.5623413251903491, 0.4216965034285822,
0.31622776601683794, 0.23713737056616552, 0.1778279410038923, 0.1333521432163324,
0.1, 0.07498942093324558, 0.05623413251903491, 0.042169650342858224,
0.03162277660168379, 0.023713737056616554, 0.01778279410038923, 0.01333521432163324,
0.01, 0.007498942093324558, 0.005623413251903491, 0.004216965034285823,
0.0031622776601683794, 0.0023713737056616554, 0.0017782794100389228, 0.001333521432163324,
0.001, 0.0007498942093324559, 0.0005623413251903491, 0.00042169650342858224,
0.00031622776601683794, 0.00023713737056616554, 0.00017782794100389227, 0.0001333521432163324};
__device__ __forceinline__ void rope_cs(int pos, int i, float& c, float& s) {
    double rev = (double)pos * ROPE_INV[i] * 0.15915494309189535;
    rev -= __builtin_rint(rev);
    const float rf = (float)rev;
    s = __builtin_amdgcn_sinf(rf); c = __builtin_amdgcn_cosf(rf);
}

__device__ __forceinline__ s16x4 vtr(const LAS unsigned char* p) {
    typedef short v4i16_t __attribute__((ext_vector_type(4)));
    return __builtin_bit_cast(s16x4, __builtin_amdgcn_ds_read_tr16_b64_v4i16((LAS v4i16_t*)p));
}
template <int DQK, class MB>
__device__ __forceinline__ void tile_qk(const LAS unsigned char* Kt, const bf16x8 (&qf)[DQK / 16], f32x16& s0, f32x16& s1, int lane, const MB& mb) {
    constexpr int KP = DQK * 2 + 16;
    const int r32 = lane & 31, hi = lane >> 5;
#pragma unroll
    for (int r = 0; r < 16; ++r) { s0[r] = 0.f; s1[r] = 0.f; }
    const LAS unsigned char* kp = Kt + r32 * KP + hi * 16;
#pragma unroll
    for (int ks = 0; ks < DQK / 16; ++ks) {
        const bf16x8 k0 = *(const LAS bf16x8*)(kp + ks * 32);
        const bf16x8 k1 = *(const LAS bf16x8*)(kp + 32 * KP + ks * 32);
        s0 = __builtin_amdgcn_mfma_f32_32x32x16_bf16(k0, qf[ks], s0, 0, 0, 0);
        s1 = __builtin_amdgcn_mfma_f32_32x32x16_bf16(k1, qf[ks], s1, 0, 0, 0);
    }
    mb(s0, s1);
}
template <int DV>
__device__ __forceinline__ void tile_pv(const LAS unsigned char* Vt, f32x16& s0, f32x16& s1, f32x16 (&o)[DV / 32], float& m, float& l, int lane) {
    constexpr int VP = DV * 2 + 64;
    const int hi = lane >> 5;
    float mx = s0[0];
#pragma unroll
    for (int r = 0; r < 16; ++r) { mx = fmaxf(mx, s0[r]); mx = fmaxf(mx, s1[r]); }
    mx = fmaxf(mx, __shfl_xor(mx, 32));
    if (__any(mx > m + 4.0f)) {
        const float mnew = fmaxf(m, mx);
        const float alpha = fexp2(m - mnew);
        m = mnew; l *= alpha;
#pragma unroll
        for (int db = 0; db < DV / 32; ++db)
#pragma unroll
            for (int r = 0; r < 16; ++r) o[db][r] *= alpha;
    }
    float ps = 0.f;
#pragma unroll
    for (int r = 0; r < 16; ++r) { s0[r] = fexp2(s0[r] - m); s1[r] = fexp2(s1[r] - m); ps += s0[r] + s1[r]; }
    ps += __shfl_xor(ps, 32);
    l += ps;
    bf16x8 pf[4];
    {
        u32x4 w;
        w.x = cvtpk(s0[0], s0[1]); w.y = cvtpk(s0[2], s0[3]); w.z = cvtpk(s0[4], s0[5]); w.w = cvtpk(s0[6], s0[7]); pf[0] = __builtin_bit_cast(bf16x8, w);
        w.x = cvtpk(s0[8], s0[9]); w.y = cvtpk(s0[10], s0[11]); w.z = cvtpk(s0[12], s0[13]); w.w = cvtpk(s0[14], s0[15]); pf[1] = __builtin_bit_cast(bf16x8, w);
        w.x = cvtpk(s1[0], s1[1]); w.y = cvtpk(s1[2], s1[3]); w.z = cvtpk(s1[4], s1[5]); w.w = cvtpk(s1[6], s1[7]); pf[2] = __builtin_bit_cast(bf16x8, w);
        w.x = cvtpk(s1[8], s1[9]); w.y = cvtpk(s1[10], s1[11]); w.z = cvtpk(s1[12], s1[13]); w.w = cvtpk(s1[14], s1[15]); pf[3] = __builtin_bit_cast(bf16x8, w);
    }
    const LAS unsigned char* vp = Vt + (4 * hi + ((lane & 15) >> 2)) * VP + (16 * ((lane >> 4) & 1) + 4 * (lane & 3)) * 2;
#pragma unroll
    for (int db = 0; db < DV / 32; ++db) {
#pragma unroll
        for (int sp = 0; sp < 4; ++sp) {
            const s16x4 lo = vtr(vp + (16 * sp) * VP + db * 64);
            const s16x4 hh = vtr(vp + (16 * sp + 8) * VP + db * 64);
            const bf16x8 vf = {lo[0], lo[1], lo[2], lo[3], hh[0], hh[1], hh[2], hh[3]};
            o[db] = __builtin_amdgcn_mfma_f32_32x32x16_bf16(vf, pf[sp], o[db], 0, 0, 0);
        }
    }
}
template <int DQK, int DV, class MB>
__device__ __forceinline__ void tile_step(const LAS unsigned char* Kt, const LAS unsigned char* Vt, const bf16x8 (&qf)[DQK / 16], f32x16 (&o)[DV / 32], float& m, float& l, int lane, const MB& mb) {
    f32x16 s0, s1;
    tile_qk<DQK>(Kt, qf, s0, s1, lane, mb);
    tile_pv<DV>(Vt, s0, s1, o, m, l, lane);
}

template <int DQK, bool FOX> struct CausalMB {
    const LAS float* ck; float cq; int qg, kv0, hi; bool need_mask;
    __device__ __forceinline__ void operator()(f32x16& s0, f32x16& s1) const {
        if constexpr (FOX) {
#pragma unroll
            for (int g = 0; g < 4; ++g) {
                const f32x4 c0 = *(const LAS f32x4*)(ck + 8 * g + 4 * hi), c1 = *(const LAS f32x4*)(ck + 32 + 8 * g + 4 * hi);
#pragma unroll
                for (int i = 0; i < 4; ++i) { s0[4 * g + i] -= c0[i]; s1[4 * g + i] -= c1[i]; }
            }
        }
        if (need_mask) {
            const int rel = qg - kv0 - 4 * hi;
#pragma unroll
            for (int r = 0; r < 16; ++r) { const int kvl = (r & 3) + 8 * (r >> 2); if (kvl > rel) s0[r] = -INFINITY; if (kvl + 32 > rel) s1[r] = -INFINITY; }
        }
    }
};

template <int DQK, bool FOX>
__device__ __forceinline__ void causal_attn_phase(LAS unsigned char* lds, const bf16_t* Q, int qpitch, const bf16_t* K1, const bf16_t* K2, const bf16_t* V, bf16_t* O, const float* cum2, const float* rope_cs_tab, const float* fox_ct) {
    constexpr int DV = 128, NKS = DQK / 16, KP = DQK * 2 + 16, VP = DV * 2 + 64;
    constexpr int KT_BYTES = 64 * KP, VT_BYTES = 64 * VP, BUF = KT_BYTES + VT_BYTES + 256;
    constexpr int NCHK = DQK / 8, NK = 64 * NCHK / 512, NV = 2;
    static_assert(2 * BUF + 1024 <= 131072, "lds");
    const int tid = ltid(), lane = tid & 63, wid = __builtin_amdgcn_readfirstlane(tid >> 6), r32 = lane & 31, hi = lane >> 5;
    for (int u = blockIdx.x; u < 512; u += gridDim.x) {
        const int rnd = u >> 8, bb = u & 255, head = bb & 15, qb = rnd == 0 ? 31 - (bb >> 4) : (bb >> 4);
        const int q0 = qb * 256, qrow = q0 + wid * 32 + r32;
        bf16x8 qf[NKS];
        { const bf16_t* qp = Q + (size_t)qrow * qpitch + head * DQK + hi * 8;
#pragma unroll
          for (int ks = 0; ks < NKS; ++ks) qf[ks] = *(const bf16x8*)(qp + ks * 16); }
        if constexpr (DQK == 192) {
#pragma unroll
            for (int sidx = 0; sidx < 2; ++sidx) {
                const f32x4* csp = (const f32x4*)(rope_cs_tab + (size_t)qrow * 64 + (16 * sidx + 8 * hi) * 2);
#pragma unroll
                for (int jj = 0; jj < 4; ++jj) { const f32x4 cs = csp[jj];
#pragma unroll
                    for (int e = 0; e < 2; ++e) { const int j = 2 * jj + e; const float c = e ? cs.z : cs.x, sn = e ? cs.w : cs.y;
                        const float x1 = bf2f((unsigned short)qf[8 + sidx][j]), x2 = bf2f((unsigned short)qf[10 + sidx][j]);
                        qf[8 + sidx][j] = (short)(cvtpk(x1 * c - x2 * sn, 0.f) & 0xffffu); qf[10 + sidx][j] = (short)(cvtpk(x2 * c + x1 * sn, 0.f) & 0xffffu); } }
            }
        }
        LAS float* offs = (LAS float*)(lds + 2 * BUF);
        if constexpr (FOX) {
            if (wid == 0) { const float a = fox_ct[head * 128 + lane], b = fox_ct[head * 128 + 64 + lane]; float ia = a, ib = b;
#pragma unroll
                for (int o_ = 1; o_ < 64; o_ <<= 1) { const float va = __shfl_up(ia, o_), vb = __shfl_up(ib, o_); if (lane >= o_) { ia += va; ib += vb; } }
                const float tota = __shfl(ia, 63);
                offs[lane] = ia - a; offs[64 + lane] = tota + (ib - b);
                float km = fmaxf(fox_ct[T + head * 128 + lane], fox_ct[T + head * 128 + 64 + lane]);
#pragma unroll
                for (int o_ = 1; o_ < 64; o_ <<= 1) km = fmaxf(km, __shfl_xor(km, o_));
                if (lane == 0) { offs[128] = km; offs[132] = 0.f; offs[133] = 0.f; offs[134] = 0.f; offs[135] = 0.f; } }
            __syncthreads();
        }
        const float cq = FOX ? (cum2[head * T + qrow] + offs[qrow >> 6]) * LOG2E : 0.f;
        f32x16 o[4];
#pragma unroll
        for (int db = 0; db < 4; ++db)
#pragma unroll
            for (int r = 0; r < 16; ++r) o[db][r] = 0.f;
        float m = -1e30f, l = 0.f;
        const int NT = (q0 + 256) / 64;
        u32x4 kreg[NK], vreg[NV]; float ckreg = 0.f;
        unsigned koff[NK], voff[NV]; bool krope[NK];
#pragma unroll
        for (int i_ = 0; i_ < NK; ++i_) { const int id_ = tid + 512 * i_, row_ = id_ / NCHK, ch_ = id_ % NCHK; krope[i_] = (DQK == 192 && ch_ >= 16);
            koff[i_] = krope[i_] ? (unsigned)(row_ * 64 + (ch_ - 16) * 8) : (unsigned)(row_ * 2048 + ch_ * 8); }
#pragma unroll
        for (int i_ = 0; i_ < NV; ++i_) { const int id_ = tid + 512 * i_, row_ = id_ >> 4, ch_ = id_ & 15; voff[i_] = (unsigned)(row_ * 2048 + ch_ * 8); }
        const bf16_t* K1h = K1 + head * 128; const bf16_t* Vh = V + head * 128;
#define CA_GLOAD(t) do { const size_t t0_ = (size_t)(t) * 64; const bf16_t* k1b_ = K1h + t0_ * 2048; const bf16_t* k2b_ = K2 + t0_ * 64; const bf16_t* vb_ = Vh + t0_ * 2048; \
            _Pragma("unroll") for (int i_ = 0; i_ < NK; ++i_) kreg[i_] = *(const u32x4*)((krope[i_] ? k2b_ : k1b_) + koff[i_]); \
            _Pragma("unroll") for (int i_ = 0; i_ < NV; ++i_) vreg[i_] = *(const u32x4*)(vb_ + voff[i_]); \
            if (FOX && tid < 64) ckreg = (cum2[head * T + (int)t0_ + tid] + offs[(t)]) * LOG2E; } while (0)
#define CA_LSTORE(b) do { LAS unsigned char* base_ = lds + (b) * BUF; \
            _Pragma("unroll") for (int i_ = 0; i_ < NK; ++i_) { const int id_ = tid + 512 * i_, row_ = id_ / NCHK, ch_ = id_ % NCHK; *(LAS u32x4*)(base_ + row_ * KP + ch_ * 16) = kreg[i_]; } \
            _Pragma("unroll") for (int i_ = 0; i_ < NV; ++i_) { const int id_ = tid + 512 * i_, row_ = id_ >> 4, ch_ = id_ & 15; *(LAS u32x4*)(base_ + KT_BYTES + row_ * VP + ch_ * 16) = vreg[i_]; } \
            if (FOX && tid < 64) *(LAS float*)(base_ + KT_BYTES + VT_BYTES + tid * 4) = ckreg; } while (0)
        if constexpr (!FOX) {
            CA_GLOAD(0); CA_LSTORE(0); __syncthreads();
            for (int t = 0; t < NT; ++t) {
                if (t + 1 < NT) CA_GLOAD(t + 1);
                const int kv0 = t * 64;
                if (kv0 <= q0 + wid * 32 + 31) {
                    const LAS unsigned char* base = lds + (t & 1) * BUF;
                    CausalMB<DQK, FOX> mb; mb.ck = (const LAS float*)(base + KT_BYTES + VT_BYTES); mb.cq = cq; mb.qg = qrow; mb.kv0 = kv0; mb.hi = hi; mb.need_mask = (kv0 + 63 > q0 + wid * 32);
                    tile_step<DQK, DV>(base, base + KT_BYTES, qf, o, m, l, lane, mb);
                }
                if (t + 1 < NT) CA_LSTORE((t + 1) & 1);
                __syncthreads();
            }
        } else {
            float qn = 0.f;
#pragma unroll
            for (int ks = 0; ks < NKS; ++ks)
#pragma unroll
                for (int j = 0; j < 8; ++j) { const float a = bf2f((unsigned short)qf[ks][j]); qn += a * a; }
            qn += __shfl_xor(qn, 32);
            qn = sqrtf(qn) * offs[128] * 1.02f + 1.0f;
            volatile LAS int* dflag = (volatile LAS int*)(offs + 136);
            bool done = false;
            CA_GLOAD(NT - 1); CA_LSTORE(0); __syncthreads();
            for (int tt = 0; tt < NT; ++tt) {
                const int t = NT - 1 - tt;
                if (t > 0) CA_GLOAD(t - 1);
                const int kv0 = t * 64;
                const LAS unsigned char* base = lds + (tt & 1) * BUF;
                const LAS float* ckp = (const LAS float*)(base + KT_BYTES + VT_BYTES);
                if (!done && kv0 <= q0 + wid * 32 + 31) {
                    const float bound = qn - ckp[63];
                    if (__all(bound - m < -150.0f)) done = true;
                    else {
                        CausalMB<DQK, FOX> mb; mb.ck = ckp; mb.cq = cq; mb.qg = qrow; mb.kv0 = kv0; mb.hi = hi; mb.need_mask = (kv0 + 63 > q0 + wid * 32);
                        tile_step<DQK, DV>(base, base + KT_BYTES, qf, o, m, l, lane, mb);
                    }
                }
                if (lane == 0) dflag[(tt & 1) * 8 + wid] = done ? 1 : 0;
                if (t > 0) CA_LSTORE((tt + 1) & 1);
                __syncthreads();
                int alld = 1;
#pragma unroll
                for (int w_ = 0; w_ < 8; ++w_) alld &= dflag[(tt & 1) * 8 + w_];
                if (alld) break;
            }
            __syncthreads();
        }
#undef CA_GLOAD
#undef CA_LSTORE
        const float il = 1.0f / l;
        bf16_t* op = O + (size_t)qrow * 2048 + head * 128 + 4 * hi;
#pragma unroll
        for (int db = 0; db < 4; ++db)
#pragma unroll
            for (int g = 0; g < 4; ++g) { u32x2 w; w.x = cvtpk(o[db][4 * g] * il, o[db][4 * g + 1] * il); w.y = cvtpk(o[db][4 * g + 2] * il, o[db][4 * g + 3] * il);
                *(u32x2*)(op + 32 * db + 8 * g) = w; }
    }
}

__device__ __forceinline__ int t5_bucket(int n) {
    if (n < 16) return n;
    const float nf = (float)n;
    int large = 16 + (int)(logf(nf / 16.f) / logf(128.f) * 16.f);
    return large < 31 ? large : 31;
}
__device__ __forceinline__ void t5_table_phase(const float* rel_bias, float* tab, int gtid, int nthreads) {
    for (int i = gtid; i < 3 * 32 * 132; i += nthreads) {
        const int ri = i / (32 * 132), h = (i / 132) & 31, j = i % 132, rate = ri == 0 ? 1 : (ri == 1 ? 4 : 16);
        tab[i] = (j <= 128) ? rel_bias[t5_bucket(rate * j) * 32 + h] * LOG2E : 0.f;
    }
}
struct BandMB {
    const LAS float* tbx; int qrel, krel0, hi;
    __device__ __forceinline__ void operator()(f32x16& s0, f32x16& s1) const {
        const LAS float* p = tbx + (qrel - krel0 - 4 * hi + 128 - 59);
#pragma unroll
        for (int r = 0; r < 16; ++r) {
            const int kvl = (r & 3) + 8 * (r >> 2);
            s0[r] += p[59 - kvl];
            s1[r] += p[27 - kvl];
        }
    }
};
template <bool SWA>
__device__ __forceinline__ void banded_attn_phase(LAS unsigned char* lds, const bf16_t* Q, const bf16_t* K, const bf16_t* V, int kvpitch, const float* t5tab  , const float* sinks,
                                                  int rate, int max_dist, int mode, float* Acc, float* Mst, float* Lst, bf16_t* O) {
    constexpr int DQK = 64, DV = 64, KP = DQK * 2 + 16, VP = DV * 2 + 64;
    constexpr int KB_BYTES = 128 * KP, VB_BYTES = 128 * VP, HALF_BYTES = KB_BYTES + VB_BYTES + 2048;
    static_assert(2 * HALF_BYTES <= 131072, "lds");
    const int tid = ltid(), lane = tid & 63, wid = __builtin_amdgcn_readfirstlane(tid >> 6), r32 = lane & 31, hi = lane >> 5;
    const int half = wid >> 2, w4 = wid & 3, th = tid & 255;
    LAS unsigned char* hb = lds + half * HALF_BYTES;
    LAS float* tb = (LAS float*)(hb + KB_BYTES + VB_BYTES);
    u32x4 kreg[4], vreg[4];
#define BD_GLOAD(uu, kk) do { const int cb_ = (uu) >> 4, c_ = cb_ % rate, b_ = cb_ / rate, head_ = ((uu) & 15) * 2 + half, kvh_ = SWA ? (head_ >> 3) : head_; const int ks0_ = (b_ - 1 + (kk)) * 128; \
        _Pragma("unroll") for (int i = 0; i < 4; ++i) { const int id = th + 256 * i, row = id >> 3, ch = id & 7; const size_t tok = (size_t)(ks0_ + row) * rate + c_; \
            kreg[i] = *(const u32x4*)(K + tok * kvpitch + kvh_ * 64 + ch * 8); vreg[i] = *(const u32x4*)(V + tok * kvpitch + kvh_ * 64 + ch * 8); } } while (0)
    const float* tabr = t5tab + (rate == 1 ? 0 : (rate == 4 ? 1 : 2)) * (32 * 132);
    bf16x8 qnext[4]; float tbnext = 0.f, tbnext2 = 0.f; float mnext = 0.f, lnext = 0.f; u32x2 onext[2][4];
#define BD_QLOAD(uu) do { const int cb_ = (uu) >> 4, c_ = cb_ % rate, b_ = cb_ / rate, head_ = ((uu) & 15) * 2 + half; const int qtok_ = (b_ * 128 + w4 * 32 + r32) * rate + c_; \
        const bf16_t* qp_ = Q + (size_t)qtok_ * 2048 + head_ * 64 + hi * 8; _Pragma("unroll") for (int ks = 0; ks < 4; ++ks) qnext[ks] = *(const bf16x8*)(qp_ + ks * 16); \
        if (mode == 1 || mode == 2) { mnext = Mst[(size_t)qtok_ * 32 + head_]; lnext = Lst[(size_t)qtok_ * 32 + head_]; const bf16_t* ap_ = O + (size_t)qtok_ * 2048 + head_ * 64 + 4 * hi; \
            _Pragma("unroll") for (int db = 0; db < 2; ++db) _Pragma("unroll") for (int g = 0; g < 4; ++g) onext[db][g] = *(const u32x2*)(ap_ + 32 * db + 8 * g); } \
        { const int d0_ = th - 128, d1_ = th + 128; tbnext = (d0_ >= 0 && d0_ <= max_dist) ? tabr[head_ * 132 + d0_] : -INFINITY; tbnext2 = (th < 128 && d1_ <= max_dist) ? tabr[head_ * 132 + d1_] : -INFINITY; } } while (0)
    if ((int)blockIdx.x < 1024) { const int u0 = blockIdx.x; BD_GLOAD(u0, (((u0 >> 4) / rate) == 0 ? 1 : 0)); BD_QLOAD(u0); }
    for (int u = blockIdx.x; u < 1024; u += gridDim.x) {
        const int hp = u & 15, cb = u >> 4, c = cb % rate, b = cb / rate;
        const int head = hp * 2 + half;
        const int qrel = w4 * 32 + r32, qtok = (b * 128 + qrel) * rate + c;
        bf16x8 qf[4];
#pragma unroll
        for (int ks = 0; ks < 4; ++ks) qf[ks] = qnext[ks];
        tb[th] = tbnext; if (th < 128) tb[256 + th] = tbnext2;
        f32x16 o[2]; float m, l;
        if (mode == 1 || mode == 2) {
            m = mnext; l = lnext;
#pragma unroll
            for (int db = 0; db < 2; ++db)
#pragma unroll
                for (int g = 0; g < 4; ++g) { const u32x2 v = onext[db][g];
                    o[db][4 * g] = __uint_as_float(v.x << 16) * l; o[db][4 * g + 1] = __uint_as_float(v.x & 0xffff0000u) * l; o[db][4 * g + 2] = __uint_as_float(v.y << 16) * l; o[db][4 * g + 3] = __uint_as_float(v.y & 0xffff0000u) * l; }
        } else {
            m = -1e30f; l = 0.f;
#pragma unroll
            for (int db = 0; db < 2; ++db)
#pragma unroll
                for (int r = 0; r < 16; ++r) o[db][r] = 0.f;
        }
        for (int kb = (b == 0 ? 1 : 0); kb < 2; ++kb) {
#pragma unroll
            for (int i = 0; i < 4; ++i) { const int id = th + 256 * i, row = id >> 3, ch = id & 7;
                *(LAS u32x4*)(hb + row * KP + ch * 16) = kreg[i]; *(LAS u32x4*)(hb + KB_BYTES + row * VP + ch * 16) = vreg[i]; }
            __syncthreads();
            if (kb == 0) BD_GLOAD(u, 1);
            else { const int un = u + (int)gridDim.x; if (un < 1024) { BD_GLOAD(un, (((un >> 4) / rate) == 0 ? 1 : 0)); BD_QLOAD(un); } }
            for (int tile = 0; tile < 2; ++tile) {
                const int krel0 = (kb - 1) * 128 + tile * 64;
                const int dmin = w4 * 32 - (krel0 + 63), dmax = w4 * 32 + 31 - krel0;
                if (dmax < 0 || dmin > max_dist) continue;
                BandMB mb; mb.tbx = tb; mb.qrel = qrel; mb.krel0 = krel0; mb.hi = hi;
                tile_step<DQK, DV>(hb + tile * 64 * KP, hb + KB_BYTES + tile * 64 * VP, qf, o, m, l, lane, mb);
            }
            __syncthreads();
        }
#undef BD_GLOAD
#undef BD_QLOAD
        if (mode == 0 || mode == 1) {
            if (hi == 0) { Mst[(size_t)qtok * 32 + head] = m; Lst[(size_t)qtok * 32 + head] = l; }
            const float sc = 1.0f / l;
            bf16_t* op = O + (size_t)qtok * 2048 + head * 64 + 4 * hi;
#pragma unroll
            for (int db = 0; db < 2; ++db)
#pragma unroll
                for (int g = 0; g < 4; ++g) { u32x2 w; w.x = cvtpk(o[db][4 * g] * sc, o[db][4 * g + 1] * sc); w.y = cvtpk(o[db][4 * g + 2] * sc, o[db][4 * g + 3] * sc);
                    *(u32x2*)(op + 32 * db + 8 * g) = w; }
        } else {
            float sc;
            if (mode == 3) { const float sk = sinks[head] * LOG2E; const float m2 = fmaxf(m, sk); const float a = fexp2(m - m2); sc = a / (l * a + fexp2(sk - m2)); }
            else sc = 1.0f / l;
            bf16_t* op = O + (size_t)qtok * 2048 + head * 64 + 4 * hi;
#pragma unroll
            for (int db = 0; db < 2; ++db)
#pragma unroll
                for (int g = 0; g < 4; ++g) { u32x2 w; w.x = cvtpk(o[db][4 * g] * sc, o[db][4 * g + 1] * sc); w.y = cvtpk(o[db][4 * g + 2] * sc, o[db][4 * g + 3] * sc);
                    *(u32x2*)(op + 32 * db + 8 * g) = w; }
        }
    }
}

__device__ __forceinline__ void mla_krope_phase(const bf16_t* LATR, const int* pos, bf16_t* KR, float* CS, int gw, int NGW, int lane) {
    for (int r2 = gw; r2 < T / 2; r2 += NGW) {
        const int row = 2 * r2 + (lane >> 5), i = lane & 31;
        float c, s; rope_cs(pos[row], i, c, s);
        *(f32x2*)(CS + (size_t)row * 64 + 2 * i) = (f32x2){c, s};
        const float x1 = bf2f(LATR[(size_t)row * 512 + i]), x2 = bf2f(LATR[(size_t)row * 512 + 32 + i]);
        const unsigned a = cvtpk(x1 * c - x2 * s, 0.f), bq = cvtpk(x2 * c + x1 * s, 0.f);
        KR[(size_t)row * 64 + i] = (bf16_t)(a & 0xffffu); KR[(size_t)row * 64 + 32 + i] = (bf16_t)(bq & 0xffffu);
    }
}
__device__ __forceinline__ void fox_scan_phase(const bf16_t* GATE  , const float* b_f, float* LPRE, float* CT, const bf16_t* Kb  , float* KMAX, int gw, int NGW, int lane) {
    for (int task = gw; task < 2048; task += NGW) {
        const int c = task >> 4, h = task & 15, t = c * 64 + lane;
        const float x = bf2f(GATE[(size_t)t * 2048 + h]) + b_f[h];
        float inc = fminf(x, 0.f) - log1pf(expf(-fabsf(x)));
#pragma unroll
        for (int o = 1; o < 64; o <<= 1) { const float v = __shfl_up(inc, o); if (lane >= o) inc += v; }
        LPRE[(size_t)h * T + t] = inc;
        if (lane == 63) CT[h * 128 + c] = inc;
        const u32x4* kp = (const u32x4*)(Kb + (size_t)t * 2048 + h * 128);
        float ss = 0.f;
#pragma unroll
        for (int i = 0; i < 16; ++i) { const u32x4 w = kp[i];
#pragma unroll
            for (int e = 0; e < 4; ++e) { const float a = __uint_as_float(w[e] << 16), b = __uint_as_float(w[e] & 0xffff0000u); ss += a * a + b * b; } }
        float nm = sqrtf(ss);
#pragma unroll
        for (int o = 1; o < 64; o <<= 1) nm = fmaxf(nm, __shfl_xor(nm, o));
        if (lane == 0) KMAX[h * 128 + c] = nm;
    }
}
__device__ __forceinline__ void conv_gate_phase(const bf16_t* U, const float* cw, const float* cb, bf16_t* G) {
    constexpr int TCH = 16, NF8 = DFF / 8, NITEMS = (T / TCH) * NF8;
    for (int it = blockIdx.x * 512 + ltid(); it < NITEMS; it += gridDim.x * 512) {
        const int f8 = it % NF8, tc = it / NF8, f0 = f8 * 8, t0 = tc * TCH;
        float wg[3][8], wv[3][8], bg[8], bv[8];
#pragma unroll
        for (int j = 0; j < 3; ++j)
#pragma unroll
            for (int e = 0; e < 8; ++e) { wg[j][e] = cw[(size_t)j * 2 * DFF + f0 + e]; wv[j][e] = cw[(size_t)j * 2 * DFF + DFF + f0 + e]; }
#pragma unroll
        for (int e = 0; e < 8; ++e) { bg[e] = cb[f0 + e]; bv[e] = cb[DFF + f0 + e]; }
        float g2[8], g1[8], v2[8], v1[8];
#pragma unroll
        for (int e = 0; e < 8; ++e) { g2[e] = g1[e] = v2[e] = v1[e] = 0.f; }
        if (t0 >= 2) {
            const u32x4 a = *(const u32x4*)(U + (size_t)(t0 - 2) * (2 * DFF) + f0), b = *(const u32x4*)(U + (size_t)(t0 - 2) * (2 * DFF) + DFF + f0);
            const u32x4 c = *(const u32x4*)(U + (size_t)(t0 - 1) * (2 * DFF) + f0), d = *(const u32x4*)(U + (size_t)(t0 - 1) * (2 * DFF) + DFF + f0);
#pragma unroll
            for (int e = 0; e < 4; ++e) { g2[2 * e] = __uint_as_float(a[e] << 16); g2[2 * e + 1] = __uint_as_float(a[e] & 0xffff0000u); v2[2 * e] = __uint_as_float(b[e] << 16); v2[2 * e + 1] = __uint_as_float(b[e] & 0xffff0000u);
                g1[2 * e] = __uint_as_float(c[e] << 16); g1[2 * e + 1] = __uint_as_float(c[e] & 0xffff0000u); v1[2 * e] = __uint_as_float(d[e] << 16); v1[2 * e + 1] = __uint_as_float(d[e] & 0xffff0000u); }
        }
#pragma unroll 4
        for (int tt = 0; tt < TCH; ++tt) {
            const int t = t0 + tt;
            const u32x4 a = *(const u32x4*)(U + (size_t)t * (2 * DFF) + f0), b = *(const u32x4*)(U + (size_t)t * (2 * DFF) + DFF + f0);
            float g0[8], v0[8], res[8];
#pragma unroll
            for (int e = 0; e < 4; ++e) { g0[2 * e] = __uint_as_float(a[e] << 16); g0[2 * e + 1] = __uint_as_float(a[e] & 0xffff0000u); v0[2 * e] = __uint_as_float(b[e] << 16); v0[2 * e + 1] = __uint_as_float(b[e] & 0xffff0000u); }
#pragma unroll
            for (int e = 0; e < 8; ++e) {
                const float cg_ = bg[e] + g2[e] * wg[0][e] + g1[e] * wg[1][e] + g0[e] * wg[2][e];
                const float cv_ = bv[e] + v2[e] * wv[0][e] + v1[e] * wv[1][e] + v0[e] * wv[2][e];
                res[e] = cg_ / (1.0f + __expf(-cg_)) * cv_;
                g2[e] = g1[e]; g1[e] = g0[e]; v2[e] = v1[e]; v1[e] = v0[e];
            }
            u32x4 w; w.x = cvtpk(res[0], res[1]); w.y = cvtpk(res[2], res[3]); w.z = cvtpk(res[4], res[5]); w.w = cvtpk(res[6], res[7]);
            *(u32x4*)(G + (size_t)t * DFF + f0) = w;
        }
    }
}

#define XB_TMO      128
#define XB_XCNT(j)  (256  + 64 * (j))
#define XB_XSUB(j)  (1280 + 64 * (j))
#define XB_XGEN(j)  (2304 + 64 * (j))
#define XB_TOP      3328
#define XB_TOPGEN   3392
#define XCD_BAR_WORDS 3456
#define XB_SPIN_CAP (1u << 18)
__device__ __forceinline__ unsigned xb_ld(unsigned* p)              { return __hip_atomic_load(p, __ATOMIC_RELAXED, __HIP_MEMORY_SCOPE_AGENT); }
__device__ __forceinline__ unsigned xb_add(unsigned* p, unsigned v) { return __hip_atomic_fetch_add(p, v, __ATOMIC_RELAXED, __HIP_MEMORY_SCOPE_AGENT); }
__device__ __forceinline__ unsigned xb_xcc_id() { return (unsigned)__builtin_amdgcn_s_getreg((3 << 11) | 20) & 0xFu; }
#define XB_SPIN(cond, bar) do { unsigned _sp = 0; while (cond) { __builtin_amdgcn_s_sleep(1); \
    if ((++_sp & 255u) == 0u) { if (xb_ld(&(bar)[XB_TMO])) break; if (_sp > XB_SPIN_CAP) { atomicAdd(&(bar)[XB_TMO], 1u); break; } } } } while (0)
struct XcdBarrier { unsigned* bar; unsigned x; volatile LAS unsigned* st; };
__device__ __forceinline__ XcdBarrier xcd_barrier_post(unsigned* bar, volatile LAS unsigned* st) {
    XcdBarrier b; b.bar = bar; b.x = xb_xcc_id(); b.st = st;
    if (threadIdx.x == 0) (void)xb_add(&bar[XB_XCNT(b.x)], 1u);
    return b;
}
__device__ __forceinline__ void xcd_barrier_complete(unsigned* bar, unsigned x, unsigned& nloc, unsigned& nx) {
    const unsigned G = gridDim.x * gridDim.y * gridDim.z;
    unsigned sum, cnt, mine, sp = 0u;
    for (;;) {
        sum = 0u; cnt = 0u; mine = 0u;
#pragma unroll
        for (unsigned j = 0; j < 16; ++j) { const unsigned c = xb_ld(&bar[XB_XCNT(j)]); sum += c; cnt += (c > 0u) ? 1u : 0u; mine = (j == x) ? c : mine; }
        if (sum == G) break;
        __builtin_amdgcn_s_sleep(1);
        if ((++sp & 255u) == 0u) { if (xb_ld(&bar[XB_TMO])) break; if (sp > XB_SPIN_CAP) { atomicAdd(&bar[XB_TMO], 1u); break; } }
    }
    nloc = mine > 0u ? mine : 1u; nx = cnt > 0u ? cnt : 1u;
}
__device__ __forceinline__ void xcd_barrier(const XcdBarrier& b) {
    asm volatile("s_waitcnt vmcnt(0)" ::: "memory");
    __syncthreads();
    if (threadIdx.x == 0) {
        unsigned* bar = b.bar;
        __builtin_amdgcn_s_waitcnt(0);
        unsigned nloc = b.st[0], nx = b.st[1];
        if (nloc == 0u) { xcd_barrier_complete(bar, b.x, nloc, nx); b.st[0] = nloc; b.st[1] = nx; }
        const unsigned old = xb_add(&bar[XB_XSUB(b.x)], 1u);
        const unsigned gen = old / nloc;
        if (old + 1u == (gen + 1u) * nloc) {
            __builtin_amdgcn_fence(__ATOMIC_RELEASE, "agent");
            asm volatile("s_waitcnt vmcnt(0)" ::: "memory");
            const unsigned og = xb_add(&bar[XB_TOP], 1u);
            const unsigned tg = og / nx;
            if (og + 1u == (tg + 1u) * nx) xb_add(&bar[XB_TOPGEN], 1u);
            else XB_SPIN(xb_ld(&bar[XB_TOPGEN]) == tg, bar);
            __builtin_amdgcn_fence(__ATOMIC_ACQUIRE, "agent");
            xb_add(&bar[XB_XGEN(b.x)], 1u);
            asm volatile("s_waitcnt vmcnt(0)" ::: "memory");
        } else {
            XB_SPIN(xb_ld(&bar[XB_XGEN(b.x)]) == gen, bar);
            __builtin_amdgcn_fence(__ATOMIC_ACQUIRE, "agent");
            asm volatile("s_waitcnt vmcnt(0)" ::: "memory");
        }
    }
    __syncthreads();
}

typedef const __attribute__((address_space(4))) Params* KParams;
__device__ __forceinline__ KParams kparams() {
    KParams k = (KParams)__builtin_amdgcn_kernarg_segment_ptr();
    asm volatile("" : "+s"(k));
    return k;
}
#define WSP(T_, off) ((T_*)(P->ws + (off)))
constexpr size_t SPLIT = QKV_STRIDE / 2;
#define GEMM_BF16(Aptr, Bptr, N_, K_, Optr, ldc_, bias_, splitc_, scale_, rss_, rinv_, nf4_) do { \
        pg8::Gemm g_{Aptr, Bptr, T, N_, K_, 0}; pg8::StaticOrder S_; S_.init(T, N_, (int)gridDim.x, (int)blockIdx.x); \
        pg8::EpiBf16 E_{Optr, ldc_, bias_, splitc_, SPLIT, scale_, rss_, rinv_, nf4_}; \
        pg8::gemm_phase<pg8::EpiBf16, pg8::StaticOrder, true, true>(lds, g_, S_, E_); } while (0)
#define GEMM_RES(Aptr, Bptr, K_, bias_, ssout_, accs_) do { \
        pg8::Gemm g_{Aptr, Bptr, T, 2048, K_, 0}; pg8::StaticOrder S_; S_.init(T, 2048, (int)gridDim.x, (int)blockIdx.x); \
        pg8::EpiRes E_{WSP(bf16_t, WS_XN), 2048, bias_, ssout_, accs_}; \
        pg8::gemm_phase<pg8::EpiRes, pg8::StaticOrder, true, true>(lds, g_, S_, E_); } while (0)
#define SSP(k) (WSP(float, WS_SS) + (size_t)(k) * T * 32)
#define IDS const int tid = ltid(), lane = tid & 63, wid = __builtin_amdgcn_readfirstlane(tid >> 6); const int gw = blockIdx.x * 8 + wid, NGW = gridDim.x * 8; (void)lane; (void)gw; (void)NGW

#ifdef PROBE_SYNC
#define GSYNC() do { xcd_barrier(xbar); xcd_barrier(xbar); } while (0)
#else
#define GSYNC() xcd_barrier(xbar)
#endif
#define FFN_IN_GEMM(layer) { KParams P = kparams(); \
        pg8::Gemm g_{WSP(bf16_t, WS_XN), WSP(bf16_t, WS_W_FFN_IN + (size_t)(layer) * 44 * MiB), 34 * 256, 11264, 2048, 1}; pg8::StaticOrder S_; S_.init(34 * 256, 11264, (int)gridDim.x, (int)blockIdx.x); \
        pg8::EpiConv E_{WSP(bf16_t, WS_G), P->ffn_conv_w + (size_t)(layer) * 3 * 11264, P->ffn_conv_b + (size_t)(layer) * 11264, SSP(2 * (layer) + 1)}; \
        pg8::gemm_phase<pg8::EpiConv, pg8::StaticOrder, true, true>(lds, g_, S_, E_); }
#define CONV_PHASE(layer) { KParams P = kparams(); conv_gate_phase(WSP(bf16_t, WS_U), P->ffn_conv_w + (size_t)(layer) * 3 * 11264, P->ffn_conv_b + (size_t)(layer) * 11264, WSP(bf16_t, WS_G)); }
#ifdef PROBE_RES
#define PROBE_RES_X(x) x
#else
#define PROBE_RES_X(x)
#endif
#ifdef PROBE_RES2
#define PROBE_RES2_X(x) x
#else
#define PROBE_RES2_X(x)
#endif
#ifdef PROBE_FFN
#define PROBE_FFN_X(layer) __syncthreads(); FFN_IN_GEMM(layer)
#else
#define PROBE_FFN_X(layer)
#endif
#ifdef PROBE_CONV
#define PROBE_CONV_X(layer) CONV_PHASE(layer)
#else
#define PROBE_CONV_X(layer)
#endif

#define SIDE_BEGIN(first_, nb_) { IDS; KParams P = kparams(); const int sf_ = (int)(((long)(first_) * (long)gridDim.x) / 256), snb_ = (int)gridDim.x - sf_; const int sb_ = (int)blockIdx.x - sf_; if (sb_ >= 0) { LAS float* scr = (LAS float*)(lds + wid * 16384); WaveSlot wslot{sb_ * 8 + wid, snb_ * 8, 0};
#define SIDE_END } }
#define CONV_FFN_IN(i, p0_, p1_) convert_weight(P->ffn_w_in + (size_t)(i) * 2048 * 11264, 2048, 11264, 11264, WSP(bf16_t, WS_W_FFN_IN + (size_t)(i) * 44 * MiB), 2, P->norm_ffn + (size_t)(i) * D, scr, wslot, lane, p0_, p1_)
#define CONV_FFN_OUT(i) convert_weight(P->ffn_w_out + (size_t)(i) * 5632 * 2048, 5632, 2048, 2048, WSP(bf16_t, WS_W_FFN_OUT + (size_t)(i) * 22 * MiB), 0, nullptr, scr, wslot, lane)
__global__ void __launch_bounds__(512) mega_fwd(Params p_unused) {
    extern __shared__ __attribute__((aligned(16))) unsigned char lds_raw[];
    LAS unsigned char* lds = (LAS unsigned char*)lds_raw;
    cg::grid_group grid = cg::this_grid();
    { LAS unsigned* misc = (LAS unsigned*)(lds + 131072); if (threadIdx.x < 64) misc[threadIdx.x] = 0u; }
    __syncthreads();
    XcdBarrier xbar;
    { KParams P = kparams(); xbar = xcd_barrier_post((unsigned*)(P->ws + WS_CTL), (volatile LAS unsigned*)(lds + 131072 + 32)); }

#define P0_BODY { \
        IDS; KParams P = kparams(); \
        LAS float* scr = (LAS float*)(lds + wid * 16384); WaveSlot wslot{gw, NGW, 0}; \
        convert_weight(P->mla_w_in, 2048, 1088, 1280, WSP(bf16_t, WS_W_MLA_IN), 0, P->norm_mix, scr, wslot, lane); \
        convert_weight(P->mla_w_qb, 512, 3072, 3072, WSP(bf16_t, WS_W_MLA_QB), 0, P->mla_g_q, scr, wslot, lane); \
        convert_weight(P->mla_w_kvb, 512, 4096, 4096, WSP(bf16_t, WS_W_MLA_KVB), 1, P->mla_g_kv, scr, wslot, lane); \
        convert_weight(P->mla_w_o, 2048, 2048, 2048, WSP(bf16_t, WS_W_MLA_O), 0, nullptr, scr, wslot, lane); \
        convert_weight(P->fox_w_in, 2048, 6160, 6400, WSP(bf16_t, WS_W_FOX_IN), 0, P->norm_mix + 3 * D, scr, wslot, lane); \
        CONV_FFN_IN(0, 0, 100); CONV_FFN_OUT(0); CONV_FFN_OUT(2); CONV_FFN_IN(2, 0, 60); \
        t5_table_phase(P->rel_bias, WSP(float, WS_CQ + 4 * MiB), gw * 64 + lane, NGW * 64); \
        const float* x = P->x; bf16_t* HB = WSP(bf16_t, WS_XN); float* ss0 = SSP(0); \
        for (int row = gw; row < T; row += NGW) p0_row(x + (size_t)row * D, HB + (size_t)row * D, ss0 + (size_t)row * 32, lane); \
    }
    P0_BODY
#ifdef PROBE_P0
    P0_BODY
#endif
    if (gridDim.y == 0xFFFFu) grid.sync();
    GSYNC();

#define LAYER_TAIL(layer, woff, HAS_BO) do { \
        GSYNC(); \
        { KParams P = kparams(); GEMM_RES(WSP(bf16_t, WS_O), WSP(bf16_t, woff), 2048, (HAS_BO ? P->swa_b_o : (const float*)nullptr), SSP(2 * (layer) + 1), 1.f); } \
        PROBE_RES_X({ KParams P = kparams(); GEMM_RES(WSP(bf16_t, WS_O), WSP(bf16_t, woff), 2048, (HAS_BO ? P->swa_b_o : (const float*)nullptr), SSP(2 * (layer) + 1), 0.f); }) \
        GSYNC(); \
        FFN_IN_GEMM(layer) \
        if ((layer) < 3) { SIDE_BEGIN(216, 40) CONV_FFN_IN((layer) + 1, ((layer) == 0 ? 35 : ((layer) == 1 ? 60 : 0)), ((layer) == 0 ? 65 : ((layer) == 1 ? 90 : 30))); SIDE_END } \
        PROBE_FFN_X(layer) \
        GSYNC(); \
        { KParams P = kparams(); GEMM_RES(WSP(bf16_t, WS_G), WSP(bf16_t, WS_W_FFN_OUT + (size_t)(layer) * 22 * MiB), 5632, (const float*)nullptr, SSP(2 * (layer) + 2), 1.f); } \
        PROBE_RES2_X({ KParams P = kparams(); GEMM_RES(WSP(bf16_t, WS_G), WSP(bf16_t, WS_W_FFN_OUT + (size_t)(layer) * 22 * MiB), 5632, (const float*)nullptr, SSP(2 * (layer) + 2), 0.f); }) \
        GSYNC(); \
    } while (0)

    { KParams P = kparams();
      pg8::Gemm g_{WSP(bf16_t, WS_XN), WSP(bf16_t, WS_W_MLA_IN), T, 1280, 2048, 0}; pg8::StaticOrder S_; S_.init(T, 1280, (int)gridDim.x, (int)blockIdx.x);
      pg8::EpiF32<false> E_{nullptr, 512, nullptr, WSP(bf16_t, WS_LAT), SSP(9), SSP(0), (size_t)(8 * MiB / 2), 1.f};
      pg8::gemm_phase<pg8::EpiF32<false>, pg8::StaticOrder, true, true>(lds, g_, S_, E_); }
    SIDE_BEGIN(160, 96)
        convert_weight(P->swa_w_qkv, 2048, 2560, 2560, WSP(bf16_t, WS_W_SWA_QKV), 0, P->norm_mix + D, scr, wslot, lane);
        convert_weight(P->swa_w_o, 2048, 2048, 2048, WSP(bf16_t, WS_W_SWA_O), 0, nullptr, scr, wslot, lane);
        CONV_FFN_IN(1, 0, 35);
    SIDE_END
    GSYNC();
    { KParams P = kparams(); GEMM_BF16(WSP(bf16_t, WS_LAT), WSP(bf16_t, WS_W_MLA_QB), 3072, 512, WSP(bf16_t, WS_Q), 3072, nullptr, 0, 0.07216878364870323f * LOG2E, SSP(9), 1.f / 512.f, 2); }
    { KParams P = kparams(); GEMM_BF16(WSP(bf16_t, WS_LAT + 8 * MiB), WSP(bf16_t, WS_W_MLA_KVB), 4096, 512, WSP(bf16_t, WS_Q + QKV_STRIDE), 2048, nullptr, 2048, 1.0f, SSP(10), 1.f / 512.f, 2); }
    { IDS; KParams P = kparams(); mla_krope_phase(WSP(bf16_t, WS_LAT + 16 * MiB), P->pos, WSP(bf16_t, WS_KROPE), WSP(float, WS_CQ), gw, NGW, lane); }
    SIDE_BEGIN(128, 128)
        convert_weight(P->dil_w_o, 2048, 2048, 2048, WSP(bf16_t, WS_W_DIL_O), 0, nullptr, scr, wslot, lane);
    SIDE_END
    GSYNC();
#define MLA_ATTN { KParams P = kparams(); causal_attn_phase<192, false>(lds, WSP(bf16_t, WS_Q), 3072, WSP(bf16_t, WS_Q + QKV_STRIDE), WSP(bf16_t, WS_KROPE), WSP(bf16_t, WS_Q + 2 * QKV_STRIDE), WSP(bf16_t, WS_O), nullptr, WSP(float, WS_CQ), nullptr); }
    MLA_ATTN
#ifdef PROBE_ATTN
    MLA_ATTN
#endif
    LAYER_TAIL(0, WS_W_MLA_O, false);

    { KParams P = kparams(); GEMM_BF16(WSP(bf16_t, WS_XN), WSP(bf16_t, WS_W_SWA_QKV), 2560, 2048, WSP(bf16_t, WS_Q), 2048, P->swa_b_qkv, 2048, 0.125f * LOG2E, SSP(2), 1.f / 2048.f, 8); }
    SIDE_BEGIN(64, 192)
        CONV_FFN_OUT(1);
        convert_weight(P->dil_w_qkv, 2048, 6144, 6144, WSP(bf16_t, WS_W_DIL_QKV), 0, P->norm_mix + 2 * D, scr, wslot, lane);
        CONV_FFN_IN(1, 65, 100);
        CONV_FFN_IN(2, 90, 100);
    SIDE_END
    GSYNC();
#define SWA_ATTN { KParams P = kparams(); banded_attn_phase<true>(lds, WSP(bf16_t, WS_Q), WSP(bf16_t, WS_Q + QKV_STRIDE), WSP(bf16_t, WS_Q + QKV_STRIDE) + 256, 2048, WSP(float, WS_CQ + 4 * MiB), P->swa_sinks, 1, 127, 3, nullptr, nullptr, nullptr, WSP(bf16_t, WS_O)); }
    SWA_ATTN
#ifdef PROBE_SWA
    SWA_ATTN
#endif
    LAYER_TAIL(1, WS_W_SWA_O, true);

    { KParams P = kparams(); GEMM_BF16(WSP(bf16_t, WS_XN), WSP(bf16_t, WS_W_DIL_QKV), 6144, 2048, WSP(bf16_t, WS_Q), 2048, nullptr, 2048, 0.125f * LOG2E, SSP(4), 1.f / 2048.f, 8); }
    for (int br = 0; br < 3; ++br) {
        GSYNC();
        KParams P = kparams();
        banded_attn_phase<false>(lds, WSP(bf16_t, WS_Q), WSP(bf16_t, WS_Q + QKV_STRIDE), WSP(bf16_t, WS_Q + 2 * QKV_STRIDE), 2048, WSP(float, WS_CQ + 4 * MiB), nullptr, br == 0 ? 1 : (br == 1 ? 4 : 16), 128, br,
                                 WSP(float, WS_ACC), WSP(float, WS_MST), WSP(float, WS_LST), WSP(bf16_t, WS_O));
    }
#ifdef PROBE_DIL
    for (int br = 0; br < 3; ++br) {
        GSYNC();
        KParams P = kparams();
        banded_attn_phase<false>(lds, WSP(bf16_t, WS_Q), WSP(bf16_t, WS_Q + QKV_STRIDE), WSP(bf16_t, WS_Q + 2 * QKV_STRIDE), 2048, WSP(float, WS_CQ + 4 * MiB), nullptr, br == 0 ? 1 : (br == 1 ? 4 : 16), 128, br,
                                 WSP(float, WS_ACC), WSP(float, WS_MST), WSP(float, WS_LST), WSP(bf16_t, WS_O));
    }
#endif
    LAYER_TAIL(2, WS_W_DIL_O, false);

    { KParams P = kparams(); GEMM_BF16(WSP(bf16_t, WS_XN), WSP(bf16_t, WS_W_FOX_IN), 6400, 2048, WSP(bf16_t, WS_Q), 2048, nullptr, 2048, 0.08838834764831845f * LOG2E, SSP(6), 1.f / 2048.f, 8); }
    SIDE_BEGIN(32, 224)
        CONV_FFN_OUT(3);
        convert_weight(P->fox_w_o, 2048, 2048, 2048, WSP(bf16_t, WS_W_FOX_O), 0, nullptr, scr, wslot, lane);
        CONV_FFN_IN(3, 30, 100);
    SIDE_END
    GSYNC();
    { IDS; KParams P = kparams(); fox_scan_phase(WSP(bf16_t, WS_Q + 3 * QKV_STRIDE), P->fox_b_f, WSP(float, WS_CUM), WSP(float, WS_CUM) + 16 * T, WSP(bf16_t, WS_Q + QKV_STRIDE), WSP(float, WS_CUM) + 17 * T, gw, NGW, lane); }
#ifdef PROBE_SCAN
    { IDS; KParams P = kparams(); fox_scan_phase(WSP(bf16_t, WS_Q + 3 * QKV_STRIDE), P->fox_b_f, WSP(float, WS_CUM), WSP(float, WS_CUM) + 16 * T, WSP(bf16_t, WS_Q + QKV_STRIDE), WSP(float, WS_CUM) + 17 * T, gw, NGW, lane); }
#endif
    GSYNC();
#define FOX_ATTN { KParams P = kparams(); causal_attn_phase<128, true>(lds, WSP(bf16_t, WS_Q), 2048, WSP(bf16_t, WS_Q + QKV_STRIDE), nullptr, WSP(bf16_t, WS_Q + 2 * QKV_STRIDE), WSP(bf16_t, WS_O), WSP(float, WS_CUM), nullptr, WSP(float, WS_CUM) + 16 * T); }
    FOX_ATTN
#ifdef PROBE_ATTN
    FOX_ATTN
#endif
    LAYER_TAIL(3, WS_W_FOX_O, false);

    { IDS; KParams P = kparams(); const bf16_t* H = WSP(bf16_t, WS_XN); const float* fn = P->final_norm; float* out = P->out; const float* ss = SSP(8);
      for (int row = gw; row < T; row += NGW) final_row(H + (size_t)row * D, fn, ss + (size_t)row * 32, out + (size_t)row * D, lane); }
}

extern "C" void kernel_launch(void* const* d_in, const int* in_sizes, int n_in, void* d_out, int out_size, void* d_ws, size_t ws_size, hipStream_t stream) {
    static int grid = 0;
    if (grid == 0) {
        if (n_in != 26 || out_size != T * D || ws_size < WS_END) { fprintf(stderr, "kernel_launch: unexpected shapes: n_in %d out %d ws %zu (need %zu)\n", n_in, out_size, ws_size, (size_t)WS_END); grid = -1; return; }
        int dev = 0, cus = 0, per_cu = 0;
        (void)hipGetDevice(&dev);
        (void)hipDeviceGetAttribute(&cus, hipDeviceAttributeMultiprocessorCount, dev);
        if (hipFuncSetAttribute((const void*)mega_fwd, hipFuncAttributeMaxDynamicSharedMemorySize, LDS_BYTES) != hipSuccess) { fprintf(stderr, "kernel_launch: hipFuncSetAttribute failed\n"); grid = -1; return; }
        if (hipOccupancyMaxActiveBlocksPerMultiprocessor(&per_cu, (const void*)mega_fwd, 512, LDS_BYTES) != hipSuccess || per_cu < 1) { fprintf(stderr, "kernel_launch: occupancy query says %d\n", per_cu); per_cu = 1; }
        (void)hipGetLastError();
        grid = cus;
    }
    if (grid < 0) return;
    if (hipMemsetAsync((char*)d_ws + WS_CTL, 0, CTL_BYTES, stream) != hipSuccess) { fprintf(stderr, "kernel_launch: memset failed\n"); return; }
    Params p{};
    p.x = (const float*)d_in[0]; p.pos = (const int*)d_in[1]; p.rel_bias = (const float*)d_in[2]; p.norm_mix = (const float*)d_in[3]; p.norm_ffn = (const float*)d_in[4];
    p.mla_w_in = (const float*)d_in[5]; p.mla_g_q = (const float*)d_in[6]; p.mla_g_kv = (const float*)d_in[7]; p.mla_w_qb = (const float*)d_in[8]; p.mla_w_kvb = (const float*)d_in[9]; p.mla_w_o = (const float*)d_in[10];
    p.swa_w_qkv = (const float*)d_in[11]; p.swa_b_qkv = (const float*)d_in[12]; p.swa_sinks = (const float*)d_in[13]; p.swa_w_o = (const float*)d_in[14]; p.swa_b_o = (const float*)d_in[15];
    p.dil_w_qkv = (const float*)d_in[16]; p.dil_w_o = (const float*)d_in[17];
    p.fox_w_in = (const float*)d_in[18]; p.fox_b_f = (const float*)d_in[19]; p.fox_w_o = (const float*)d_in[20];
    p.ffn_w_in = (const float*)d_in[21]; p.ffn_conv_w = (const float*)d_in[22]; p.ffn_conv_b = (const float*)d_in[23]; p.ffn_w_out = (const float*)d_in[24];
    p.final_norm = (const float*)d_in[25];
    p.out = (float*)d_out; p.ws = (unsigned char*)d_ws;
    void* args[] = {&p};
    hipError_t e = hipLaunchCooperativeKernel((const void*)mega_fwd, dim3(grid), dim3(512), args, LDS_BYTES, stream);
    if (e != hipSuccess) fprintf(stderr, "cooperative launch failed: %s (grid %d)\n", hipGetErrorString(e), grid);
}
```

```cpp
#include <hip/hip_runtime.h>
#include <hip/hip_cooperative_groups.h>
#include <cstdio>
#include <cstdint>
namespace cg = cooperative_groups;

#define LAS __attribute__((address_space(3)))
typedef unsigned short bf16_t;

__device__ __forceinline__ int ltid() { int t = threadIdx.x; asm volatile("" : "+v"(t)); return t; }
namespace pg8 {
#define PG8_LAS __attribute__((address_space(3)))
typedef short bf16x8 __attribute__((ext_vector_type(8)));
typedef float f32x4 __attribute__((ext_vector_type(4)));
typedef unsigned u32x4 __attribute__((ext_vector_type(4)));
constexpr int BM = 256, BK = 64, HALF = 128, HTB = HALF * BK * 2, STAGE_BYTES = 8 * HTB, NXCD = 8, WGM = 4;

__host__ __device__ __forceinline__ int lds_byte(int r, int c) { const int st = (r >> 4) * 2 + (c >> 5), rr = r & 15, cc = c & 31, ob = rr * 64 + cc * 2; return st * 1024 + (ob ^ (((ob >> 9) & 1) << 5)); }
__host__ __device__ __forceinline__ void stage_rc(int b, int& R, int& C) { const int st = b / 1024, sb = b % 1024, swz = sb ^ (((sb >> 9) & 1) << 5); R = (st >> 1) * 16 + swz / 64; C = (st & 1) * 32 + (swz % 64) / 2; }
__host__ __device__ __forceinline__ int perm32(int rho) { const int n = rho >> 4, i = rho & 15; return 8 * (i >> 2) + 4 * n + (i & 3); }

struct Unit { int pm, pn; };
struct Gemm { const bf16_t* A; const bf16_t* Bt; int M, N, K; int amode; };

struct StaticOrder {
    int nM, nN, nwg, G, c;
    __host__ __device__ void init(int M, int N, int G_, int c_) { nM = M / BM; nN = N / BM; nwg = nM * nN; G = G_; c = c_; }
    __host__ __device__ bool next(int i, Unit& u) const {
        const long L = (long)i * G + c; if (L >= nwg) return false;
        int wgid = (int)L; { const int q = nwg / NXCD, r = nwg % NXCD, xcd = wgid % NXCD, off = wgid / NXCD; wgid = (xcd < r ? xcd * (q + 1) : r * (q + 1) + (xcd - r) * q) + off; }
        const int nig = WGM * nN, gid = wgid / nig, fm = gid * WGM, gsz = (nM - fm) < WGM ? (nM - fm) : WGM;
        u.pm = fm + ((wgid % nig) % gsz); u.pn = (wgid % nig) / gsz; return true;
    }
    __device__ __forceinline__ void a_ready(const Unit&) const {}
    __device__ __forceinline__ void done(const Unit&) const {}
};

__device__ __forceinline__ unsigned cvt_pk_bf16(float lo, float hi) { unsigned r; asm volatile("v_cvt_pk_bf16_f32 %0, %1, %2" : "=v"(r) : "v"(lo), "v"(hi)); return r; }

__device__ __forceinline__ float row_ss(const float* part, int row, int fq, int nf4) {
    const f32x4* p = (const f32x4*)(part + (size_t)row * 32);
    float s = 0.f;
#pragma unroll
    for (int j = 0; j < 2; ++j) { const int idx = fq + 4 * j; if (idx < nf4) { const f32x4 v = p[idx]; s += (v[0] + v[1]) + (v[2] + v[3]); } }
    s += __shfl_xor(s, 16); s += __shfl_xor(s, 32);
    return s;
}
struct EpiBf16 {
    static constexpr bool PERM = true, AFTER_DRAIN = false;
    bf16_t* O; int ldc; const float* bias; int split_cols; size_t split_stride; float scale0; const float* rss; float rinv; int nf4;
    __device__ __forceinline__ void operator()(const f32x4 (&acc)[2][2][4][2], const Unit& u, int wr, int wc, int fr, int fq) const {
        const int row0 = u.pm * BM + wr * 64 + fr; int colt = u.pn * BM; bf16_t* base = O;
        float sc = 1.f; if (split_cols) { const int t = colt / split_cols; base += (size_t)t * split_stride; colt -= t * split_cols; if (t == 0) sc = scale0; } else sc = scale0;
        const int col0 = colt + wc * 32 + 8 * fq, bcol0 = u.pn * BM + wc * 32 + 8 * fq;
        f32x4 bv[2][2];
#pragma unroll
        for (int bj = 0; bj < 2; ++bj)
#pragma unroll
            for (int n = 0; n < 2; ++n) bv[bj][n] = bias ? *(const f32x4*)(bias + bcol0 + bj * HALF + 4 * n) : (f32x4){0.f, 0.f, 0.f, 0.f};
#pragma unroll
        for (int ai = 0; ai < 2; ++ai)
#pragma unroll
            for (int m = 0; m < 4; ++m) { const int row = row0 + ai * HALF + m * 16; bf16_t* rowp = base + (size_t)row * ldc + col0;
                const float rs = rss ? __builtin_amdgcn_rsqf(row_ss(rss, row, fq, nf4) * rinv + 1e-6f) : 1.f;
#pragma unroll
                for (int bj = 0; bj < 2; ++bj) { f32x4 v0 = acc[ai][bj][m][0] * rs + bv[bj][0], v1 = acc[ai][bj][m][1] * rs + bv[bj][1];
                    v0 = v0 * sc; v1 = v1 * sc; u32x4 w; w.x = cvt_pk_bf16(v0[0], v0[1]); w.y = cvt_pk_bf16(v0[2], v0[3]); w.z = cvt_pk_bf16(v1[0], v1[1]); w.w = cvt_pk_bf16(v1[2], v1[3]);
                    *(u32x4*)(rowp + bj * HALF) = w; } }
    }
};
template <bool RESID> struct EpiF32 {
    static constexpr bool PERM = false, AFTER_DRAIN = false;
    float* H; int ldc; const float* bias; bf16_t* HB; float* ssout; const float* rss; size_t grp_stride; float accs;
    __device__ __forceinline__ void operator()(const f32x4 (&acc)[2][2][4][2], const Unit& u, int wr, int wc, int fr, int fq) const {
        typedef unsigned u32x2_t __attribute__((ext_vector_type(2)));
        const int row0 = u.pm * BM + wr * 64 + fr, col0 = (RESID ? u.pn * BM : (u.pn & 1) * BM) + wc * 32 + 4 * fq;
        bf16_t* hb = HB + (RESID ? (size_t)0 : (size_t)(u.pn >> 1) * grp_stride);
        f32x4 bv[2][2];
#pragma unroll
        for (int bj = 0; bj < 2; ++bj)
#pragma unroll
            for (int n = 0; n < 2; ++n) bv[bj][n] = (RESID && bias) ? *(const f32x4*)(bias + col0 + bj * HALF + 16 * n) : (f32x4){0.f, 0.f, 0.f, 0.f};
        float* ssp = ssout + (RESID ? (size_t)(u.pn * 4 + wc) : (size_t)8192 * 32 * (u.pn >> 1) + (u.pn & 1) * 4 + wc);
#pragma unroll
        for (int ai = 0; ai < 2; ++ai)
#pragma unroll
            for (int m = 0; m < 4; ++m) { const int row = row0 + ai * HALF + m * 16; const size_t roff = (size_t)row * ldc + col0;
                const float rs = (!RESID && rss) ? __builtin_amdgcn_rsqf(row_ss(rss, row, fq, 8) * (1.f / 2048.f) + 1e-6f) : 1.f;
                float ss = 0.f;
#pragma unroll
                for (int bj = 0; bj < 2; ++bj)
#pragma unroll
                    for (int n = 0; n < 2; ++n) { f32x4 v;
                        if (RESID) { f32x4* p = (f32x4*)(H + roff + bj * HALF + 16 * n); v = (acc[ai][bj][m][n] + bv[bj][n]) * accs + *p; *p = v; }
                        else v = acc[ai][bj][m][n] * rs;
                        ss += (v[0] * v[0] + v[1] * v[1]) + (v[2] * v[2] + v[3] * v[3]);
                        u32x2_t w; w.x = cvt_pk_bf16(v[0], v[1]); w.y = cvt_pk_bf16(v[2], v[3]);
                        *(u32x2_t*)(hb + roff + bj * HALF + 16 * n) = w; }
                ss += __shfl_xor(ss, 16); ss += __shfl_xor(ss, 32);
                if (fq == 0) ssp[(size_t)row * 32] = ss;
                if (m & 1) asm volatile("" ::: "memory"); }
    }
};

struct EpiRes {
    static constexpr bool PERM = true, AFTER_DRAIN = false;
    bf16_t* HB; int ldc; const float* bias; float* ssout; float accs;
    __device__ __forceinline__ void operator()(const f32x4 (&acc)[2][2][4][2], const Unit& u, int wr, int wc, int fr, int fq) const {
        const int row0 = u.pm * BM + wr * 64 + fr, col0 = u.pn * BM + wc * 32 + 8 * fq;
        f32x4 bv[2][2];
#pragma unroll
        for (int bj = 0; bj < 2; ++bj)
#pragma unroll
            for (int n = 0; n < 2; ++n) bv[bj][n] = bias ? *(const f32x4*)(bias + col0 + bj * HALF + 4 * n) : (f32x4){0.f, 0.f, 0.f, 0.f};
        float* ssp = ssout + (size_t)(u.pn * 4 + wc);
#pragma unroll
        for (int ai = 0; ai < 2; ++ai) {
            u32x4 old[4][2];
#pragma unroll
            for (int m = 0; m < 4; ++m)
#pragma unroll
                for (int bj = 0; bj < 2; ++bj) old[m][bj] = *(const u32x4*)(HB + (size_t)(row0 + ai * HALF + m * 16) * ldc + col0 + bj * HALF);
#pragma unroll
            for (int m = 0; m < 4; ++m) { const int row = row0 + ai * HALF + m * 16; float ss = 0.f;
#pragma unroll
                for (int bj = 0; bj < 2; ++bj) { const u32x4 ow = old[m][bj];
                    f32x4 v0 = (acc[ai][bj][m][0] + bv[bj][0]) * accs, v1 = (acc[ai][bj][m][1] + bv[bj][1]) * accs;
                    v0[0] += __uint_as_float(ow.x << 16); v0[1] += __uint_as_float(ow.x & 0xffff0000u); v0[2] += __uint_as_float(ow.y << 16); v0[3] += __uint_as_float(ow.y & 0xffff0000u);
                    v1[0] += __uint_as_float(ow.z << 16); v1[1] += __uint_as_float(ow.z & 0xffff0000u); v1[2] += __uint_as_float(ow.w << 16); v1[3] += __uint_as_float(ow.w & 0xffff0000u);
                    ss += (v0[0] * v0[0] + v0[1] * v0[1]) + (v0[2] * v0[2] + v0[3] * v0[3]) + (v1[0] * v1[0] + v1[1] * v1[1]) + (v1[2] * v1[2] + v1[3] * v1[3]);
                    u32x4 w; w.x = cvt_pk_bf16(v0[0], v0[1]); w.y = cvt_pk_bf16(v0[2], v0[3]); w.z = cvt_pk_bf16(v1[0], v1[1]); w.w = cvt_pk_bf16(v1[2], v1[3]);
                    *(u32x4*)(HB + (size_t)row * ldc + col0 + bj * HALF) = w; }
                ss += __shfl_xor(ss, 16); ss += __shfl_xor(ss, 32);
                if (fq == 0) ssp[(size_t)row * 32] = ss; }
            asm volatile("" ::: "memory");
        }
    }
};

__device__ __forceinline__ float dpp_up1(float x) { return __builtin_bit_cast(float, __builtin_amdgcn_update_dpp(0, __builtin_bit_cast(int, x), 0x111, 0xf, 0xf, true)); }
struct EpiConv {
    static constexpr bool PERM = true, AFTER_DRAIN = false;
    bf16_t* G; const float* cw; const float* cb; const float* rss;
    __device__ __forceinline__ void operator()(const f32x4 (&acc)[2][2][4][2], const Unit& u, int wr, int wc, int fr, int fq) const {
        typedef unsigned u32x2_t __attribute__((ext_vector_type(2)));
        constexpr int DFF_ = 5632, TT = 8192;
        u32x2_t stash[2][4];
        const bool edge = (u.pm == 0) || (248 * u.pm + 248 > TT);
        float rs[2][4];
#pragma unroll
        for (int ai = 0; ai < 2; ++ai)
#pragma unroll
            for (int m = 0; m < 4; ++m) { const int g = 248 * u.pm + 62 * (2 * ai + wr) - 2 + 4 * fr + m; const bool ok = g >= 0 && g < TT;
                const float ss = row_ss(rss, ok ? g : 0, fq, 8);
                rs[ai][m] = ok ? __builtin_amdgcn_rsqf(ss * (1.f / 2048.f) + 1e-6f) : 0.f; }
#pragma unroll
        for (int n = 0; n < 2; ++n) {
            const int f0 = u.pn * 128 + wc * 32 + 8 * fq + 4 * n;
            const f32x4 w0g = *(const f32x4*)(cw + f0), w1g = *(const f32x4*)(cw + 2 * DFF_ + f0), w2g = *(const f32x4*)(cw + 4 * DFF_ + f0), bg = *(const f32x4*)(cb + f0);
            const f32x4 w0v = *(const f32x4*)(cw + DFF_ + f0), w1v = *(const f32x4*)(cw + 3 * DFF_ + f0), w2v = *(const f32x4*)(cw + 5 * DFF_ + f0), bv = *(const f32x4*)(cb + DFF_ + f0);
#pragma unroll
            for (int ai = 0; ai < 2; ++ai) {
                const int g0 = 248 * u.pm + 62 * (2 * ai + wr) - 2 + 4 * fr;
                f32x4 xg[4], xv[4];
#pragma unroll
                for (int m = 0; m < 4; ++m) { const float r = rs[ai][m];
#pragma unroll
                    for (int e = 0; e < 4; ++e) { xg[m][e] = acc[ai][0][m][n][e] * r; xv[m][e] = acc[ai][1][m][n][e] * r; } }
                if (edge) {
#pragma unroll
                    for (int m = 0; m < 4; ++m) { const bool z = rs[ai][m] == 0.f;
#pragma unroll
                        for (int e = 0; e < 4; ++e) { xg[m][e] = z ? 0.f : xg[m][e]; xv[m][e] = z ? 0.f : xv[m][e]; } }
                }
                f32x4 pg2, pg3, pv2, pv3;
#pragma unroll
                for (int e = 0; e < 4; ++e) { pg2[e] = dpp_up1(xg[2][e]); pg3[e] = dpp_up1(xg[3][e]); pv2[e] = dpp_up1(xv[2][e]); pv3[e] = dpp_up1(xv[3][e]); }
#pragma unroll
                for (int m = 0; m < 4; ++m) {
                    u32x2_t w; float o[4];
#pragma unroll
                    for (int e = 0; e < 4; ++e) {
                        const float g1 = m >= 1 ? xg[m - (m >= 1 ? 1 : 0)][e] : pg3[e], g2 = m >= 2 ? xg[m - (m >= 2 ? 2 : 0)][e] : (m == 1 ? pg3[e] : pg2[e]);
                        const float v1 = m >= 1 ? xv[m - (m >= 1 ? 1 : 0)][e] : pv3[e], v2 = m >= 2 ? xv[m - (m >= 2 ? 2 : 0)][e] : (m == 1 ? pv3[e] : pv2[e]);
                        const float cg_ = bg[e] + w0g[e] * g2 + w1g[e] * g1 + w2g[e] * xg[m][e];
                        const float cv_ = bv[e] + w0v[e] * v2 + w1v[e] * v1 + w2v[e] * xv[m][e];
                        o[e] = cg_ * __builtin_amdgcn_rcpf(1.0f + __expf(-cg_)) * cv_;
                    }
                    w.x = cvt_pk_bf16(o[0], o[1]); w.y = cvt_pk_bf16(o[2], o[3]);
                    const int g = g0 + m;
                    if (n == 0) stash[ai][m] = w;
                    else if ((fr > 0 || m >= 2) && g < TT) { u32x4 ww; ww.x = stash[ai][m].x; ww.y = stash[ai][m].y; ww.z = w.x; ww.w = w.y; *(u32x4*)(G + (size_t)g * DFF_ + f0 - 4) = ww; }
                }
            }
        }
    }
};

template <class Epi, class Sched, bool ALIGN_EPI = false, bool SP2 = false>
__device__ __forceinline__ void gemm_phase(PG8_LAS unsigned char* lds, const Gemm g, const Sched& S, const Epi& E) {
    const int tid = ltid(), wid = __builtin_amdgcn_readfirstlane(tid >> 6), lane = tid & 63, wr = wid >> 2, wc = wid & 3, fr = lane & 15, fq = lane >> 4;
    const int K = g.K, nt = K / BK;
    unsigned voffA[2], voffB[2];
#pragma unroll
    for (int i = 0; i < 2; ++i) { int R, C; stage_rc(tid * 16 + i * 8192, R, C); const int Rb = Epi::PERM ? ((R & ~31) + perm32(R & 31)) : R;
        const int Ra = g.amode ? (62 * (R >> 6) + 4 * (R & 15) + ((R >> 4) & 3)) : R;
        voffA[i] = (unsigned)(Ra * K + C) * 2u; voffB[i] = (unsigned)(Rb * K + C) * 2u; }
    const size_t kstep = (size_t)(BK * 2);
    const size_t hstep = (size_t)HALF * K * 2;
    const size_t tstep = 2 * hstep;
    const size_t hstepA = g.amode ? (size_t)124 * K * 2 : hstep, tstepA = 2 * hstepA;
    const char* Abase = (const char*)g.A - (g.amode ? (size_t)2 * K * 2 : (size_t)0);
    const unsigned ldsw = (unsigned)wid * 1024u;
    const int aoff = lds_byte(wr * 64 + fr, fq * 8), boff = lds_byte(wc * 32 + fr, fq * 8);
#define PG8_SA(b, h) (((b) * 2 + (h)) * HTB)
#define PG8_SB(b, h) ((4 + (b) * 2 + (h)) * HTB)
#define PG8_STAGE(bufoff, gbase, voff) do { _Pragma("unroll") for (int _i = 0; _i < 2; ++_i) \
        __builtin_amdgcn_global_load_lds((const unsigned*)((const char*)(gbase) + (voff)[_i]), (PG8_LAS unsigned*)(lds + (bufoff) + ldsw + _i * 8192), 16, 0, 0); } while (0)
#define PG8_LDA(dst, b, h) do { _Pragma("unroll") for (int m = 0; m < 4; ++m) _Pragma("unroll") for (int k = 0; k < 2; ++k) dst[m][k] = *(const PG8_LAS bf16x8*)(lds + PG8_SA(b, h) + aoff + m * 2048 + k * 1024); } while (0)
#define PG8_LDB(dst, b, h) do { _Pragma("unroll") for (int n = 0; n < 2; ++n) _Pragma("unroll") for (int k = 0; k < 2; ++k) dst[n][k] = *(const PG8_LAS bf16x8*)(lds + PG8_SB(b, h) + boff + n * 2048 + k * 1024); } while (0)
#define PG8_MMA(ai, bj, At, Bt) do { __builtin_amdgcn_s_setprio(1); _Pragma("unroll") for (int m = 0; m < 4; ++m) _Pragma("unroll") for (int n = 0; n < 2; ++n) _Pragma("unroll") for (int k = 0; k < 2; ++k) \
        acc[ai][bj][m][n] = __builtin_amdgcn_mfma_f32_16x16x32_bf16(Bt[n][k], At[m][k], acc[ai][bj][m][n], 0, 0, 0); __builtin_amdgcn_s_setprio(0); } while (0)
#define PG8_WAIT_V(n) asm volatile("s_waitcnt vmcnt(" #n ")" ::: "memory")
#define PG8_WAIT_L(n) asm volatile("s_waitcnt lgkmcnt(" #n ")" ::: "memory")
#define PG8_BAR __builtin_amdgcn_s_barrier()
#define PG8_SCHED __builtin_amdgcn_sched_barrier(0)
    Unit cur, nxt; int ui = 0;
    if (!S.next(0, cur)) return;
    f32x4 acc[2][2][4][2];
#pragma unroll
    for (int a = 0; a < 2; ++a)
#pragma unroll
        for (int b = 0; b < 2; ++b)
#pragma unroll
            for (int m = 0; m < 4; ++m)
#pragma unroll
                for (int n = 0; n < 2; ++n) acc[a][b][m][n] = (f32x4){0.f, 0.f, 0.f, 0.f};
    bf16x8 At[4][2], B0[2][2], B1[2][2];
    const char* cA = Abase + (size_t)cur.pm * tstepA; const char* cB = (const char*)g.Bt + (size_t)cur.pn * tstep;
    S.a_ready(cur);
    if constexpr (SP2) {
        PG8_STAGE(PG8_SB(0, 0), cB, voffB); PG8_STAGE(PG8_SB(0, 1), cB + hstep, voffB); PG8_STAGE(PG8_SA(0, 0), cA, voffA); PG8_STAGE(PG8_SA(0, 1), cA + hstepA, voffA);
        if (wr == 1) PG8_BAR;
        PG8_WAIT_V(2); PG8_BAR;
        PG8_STAGE(PG8_SB(1, 0), cB + kstep, voffB); PG8_STAGE(PG8_SA(1, 0), cA + kstep, voffA); PG8_STAGE(PG8_SB(1, 1), cB + hstep + kstep, voffB);
        PG8_WAIT_V(6); PG8_BAR;
    } else {
        PG8_STAGE(PG8_SB(0, 0), cB, voffB); PG8_STAGE(PG8_SA(0, 0), cA, voffA); PG8_STAGE(PG8_SB(0, 1), cB + hstep, voffB); PG8_STAGE(PG8_SA(0, 1), cA + hstepA, voffA);
        if (wr == 1) PG8_BAR;
        PG8_WAIT_V(4); PG8_BAR;
        PG8_STAGE(PG8_SB(1, 0), cB + kstep, voffB); PG8_STAGE(PG8_SA(1, 0), cA + kstep, voffA); PG8_STAGE(PG8_SB(1, 1), cB + hstep + kstep, voffB);
        PG8_WAIT_V(6); PG8_BAR;
    }
    for (;;) {
        const bool has_next = S.next(ui + 1, nxt);
        const char* nA = has_next ? Abase + (size_t)nxt.pm * tstepA : cA; const char* nB = has_next ? (const char*)g.Bt + (size_t)nxt.pn * tstep : cB;
        for (int t = 0; t < nt; t += 2) {
            const bool last = (t == nt - 2);
            const char* a1 = cA + (size_t)(t + 1) * kstep;
            const char* a2 = last ? nA : cA + (size_t)(t + 2) * kstep; const char* b2 = last ? nB : cB + (size_t)(t + 2) * kstep;
            const char* a3 = a2 + kstep; const char* b3 = b2 + kstep;
            if (last && has_next) S.a_ready(nxt);
            if constexpr (SP2) {
            PG8_LDB(B0, 0, 0); PG8_LDB(B1, 0, 1); PG8_SCHED; PG8_LDA(At, 0, 0); PG8_STAGE(PG8_SA(1, 1), a1 + hstepA, voffA);
            PG8_WAIT_V(8); PG8_WAIT_L(0); PG8_BAR; PG8_MMA(0, 0, At, B0); PG8_MMA(0, 1, At, B1); PG8_BAR; PG8_SCHED;
            PG8_LDA(At, 0, 1); PG8_STAGE(PG8_SB(0, 0), b2, voffB); PG8_STAGE(PG8_SB(0, 1), b2 + hstep, voffB); PG8_STAGE(PG8_SA(0, 0), a2, voffA);
            PG8_WAIT_V(8); PG8_WAIT_L(0); PG8_BAR; PG8_MMA(1, 0, At, B0); PG8_MMA(1, 1, At, B1); PG8_BAR; PG8_SCHED;
            PG8_LDB(B0, 1, 0); PG8_LDB(B1, 1, 1); PG8_SCHED; PG8_LDA(At, 1, 0); PG8_STAGE(PG8_SA(0, 1), a2 + hstepA, voffA);
            PG8_WAIT_V(8); PG8_WAIT_L(0); PG8_BAR; PG8_MMA(0, 0, At, B0); PG8_MMA(0, 1, At, B1); PG8_BAR; PG8_SCHED;
            PG8_LDA(At, 1, 1); PG8_STAGE(PG8_SB(1, 0), b3, voffB); PG8_STAGE(PG8_SB(1, 1), b3 + hstep, voffB); PG8_STAGE(PG8_SA(1, 0), a3, voffA);
            PG8_WAIT_V(8); PG8_WAIT_L(0); PG8_BAR; PG8_MMA(1, 0, At, B0); PG8_MMA(1, 1, At, B1); PG8_BAR; PG8_SCHED;
            } else {
            PG8_LDB(B0, 0, 0); PG8_SCHED; PG8_LDA(At, 0, 0); PG8_STAGE(PG8_SA(1, 1), a1 + hstepA, voffA);
            PG8_WAIT_L(8); PG8_BAR; PG8_WAIT_L(0); PG8_MMA(0, 0, At, B0); PG8_BAR; PG8_SCHED;
            PG8_LDB(B1, 0, 1); PG8_STAGE(PG8_SB(0, 0), b2, voffB);
            PG8_BAR; PG8_WAIT_L(0); PG8_MMA(0, 1, At, B1); PG8_BAR;
            PG8_LDA(At, 0, 1); PG8_STAGE(PG8_SA(0, 0), a2, voffA);
            PG8_BAR; PG8_WAIT_L(0); PG8_MMA(1, 0, At, B0); PG8_BAR; PG8_SCHED;
            PG8_STAGE(PG8_SB(0, 1), b2 + hstep, voffB);
            PG8_WAIT_V(6); PG8_BAR; PG8_MMA(1, 1, At, B1); PG8_BAR;
            PG8_LDB(B0, 1, 0); PG8_SCHED; PG8_LDA(At, 1, 0); PG8_STAGE(PG8_SA(0, 1), a2 + hstepA, voffA);
            PG8_WAIT_L(8); PG8_BAR; PG8_WAIT_L(0); PG8_MMA(0, 0, At, B0); PG8_BAR; PG8_SCHED;
            PG8_LDB(B1, 1, 1); PG8_STAGE(PG8_SB(1, 0), b3, voffB);
            PG8_BAR; PG8_WAIT_L(0); PG8_MMA(0, 1, At, B1); PG8_BAR;
            PG8_LDA(At, 1, 1); PG8_STAGE(PG8_SA(1, 0), a3, voffA);
            PG8_BAR; PG8_WAIT_L(0); PG8_MMA(1, 0, At, B0); PG8_BAR; PG8_SCHED;
            PG8_STAGE(PG8_SB(1, 1), b3 + hstep, voffB);
            PG8_WAIT_V(6); PG8_BAR; PG8_MMA(1, 1, At, B1); PG8_BAR;
            }
        }
        if constexpr (ALIGN_EPI) { if (wr == 0) PG8_BAR; }
        if constexpr (!Epi::AFTER_DRAIN) { E(acc, cur, wr, wc, fr, fq); S.done(cur); }
        if (!has_next) break;
#pragma unroll
        for (int a = 0; a < 2; ++a)
#pragma unroll
            for (int b = 0; b < 2; ++b)
#pragma unroll
                for (int m = 0; m < 4; ++m)
#pragma unroll
                    for (int n = 0; n < 2; ++n) acc[a][b][m][n] = (f32x4){0.f, 0.f, 0.f, 0.f};
        cur = nxt; cA = nA; cB = nB; ++ui;
        if constexpr (ALIGN_EPI) { if (wr == 1) PG8_BAR; }
    }
    PG8_WAIT_V(0);
    if constexpr (!ALIGN_EPI) { if (wr == 0) PG8_BAR; }
    PG8_BAR;
#undef PG8_SA
#undef PG8_SB
#undef PG8_STAGE
#undef PG8_LDA
#undef PG8_LDB
#undef PG8_MMA
#undef PG8_WAIT_V
#undef PG8_WAIT_L
#undef PG8_BAR
#undef PG8_SCHED
}
}

constexpr int T = 8192, D = 2048, DFF = 5632;
constexpr float EPS = 1e-6f;
constexpr float LOG2E = 1.4426950408889634f;
constexpr size_t MiB = 1u << 20;
constexpr size_t WS_W_MLA_IN = 0;
constexpr size_t WS_W_MLA_QB = WS_W_MLA_IN + 5 * MiB;
constexpr size_t WS_W_MLA_KVB = WS_W_MLA_QB + 3 * MiB;
constexpr size_t WS_W_MLA_O = WS_W_MLA_KVB + 4 * MiB;
constexpr size_t WS_W_SWA_QKV = WS_W_MLA_O + 8 * MiB;
constexpr size_t WS_W_SWA_O = WS_W_SWA_QKV + 10 * MiB;
constexpr size_t WS_W_DIL_QKV = WS_W_SWA_O + 8 * MiB;
constexpr size_t WS_W_DIL_O = WS_W_DIL_QKV + 24 * MiB;
constexpr size_t WS_W_FOX_IN = WS_W_DIL_O + 8 * MiB;
constexpr size_t WS_W_FOX_O = WS_W_FOX_IN + 25 * MiB;
constexpr size_t WS_W_FFN_IN = WS_W_FOX_O + 8 * MiB;
constexpr size_t WS_W_FFN_OUT = WS_W_FFN_IN + 176 * MiB;
constexpr size_t WS_H = WS_W_FFN_OUT + 88 * MiB;
constexpr size_t WS_XN = WS_H + 64 * MiB;
constexpr size_t WS_U = WS_XN + 32 * MiB;
constexpr size_t WS_G = WS_U + 176 * MiB;
constexpr size_t WS_Q = WS_G + 88 * MiB;
constexpr size_t QKV_STRIDE = 48 * MiB;
constexpr size_t WS_O = WS_Q + 4 * QKV_STRIDE;
constexpr size_t WS_LAT = WS_O + 32 * MiB;
constexpr size_t WS_CQ = WS_LAT + 40 * MiB;
constexpr size_t WS_CKV = WS_CQ + 8 * MiB;
constexpr size_t WS_KROPE = WS_CKV + 8 * MiB;
constexpr size_t WS_CUM = WS_KROPE + 1 * MiB;
constexpr size_t WS_ACC = WS_CUM + 1 * MiB;
constexpr size_t WS_MST = WS_ACC + 64 * MiB;
constexpr size_t WS_LST = WS_MST + 1 * MiB;
constexpr size_t WS_CTL = WS_LST + 1 * MiB;
constexpr size_t CTL_BYTES = 65536;
constexpr size_t WS_SS = WS_CTL + 1 * MiB;
constexpr size_t WS_END = WS_SS + 12 * MiB;

constexpr int LDS_BYTES = 131072 + 1024;

struct Params {
    const float* x; const int* pos; const float* rel_bias; const float* norm_mix; const float* norm_ffn;
    const float* mla_w_in; const float* mla_g_q; const float* mla_g_kv; const float* mla_w_qb; const float* mla_w_kvb; const float* mla_w_o;
    const float* swa_w_qkv; const float* swa_b_qkv; const float* swa_sinks; const float* swa_w_o; const float* swa_b_o;
    const float* dil_w_qkv; const float* dil_w_o;
    const float* fox_w_in; const float* fox_b_f; const float* fox_w_o;
    const float* ffn_w_in; const float* ffn_conv_w; const float* ffn_conv_b; const float* ffn_w_out;
    const float* final_norm;
    float* out; unsigned char* ws;
};

typedef short bf16x8 __attribute__((ext_vector_type(8)));
typedef short s16x4 __attribute__((ext_vector_type(4)));
typedef float f32x16 __attribute__((ext_vector_type(16)));
typedef float f32x4 __attribute__((ext_vector_type(4)));
typedef float f32x2 __attribute__((ext_vector_type(2)));
typedef unsigned u32x4 __attribute__((ext_vector_type(4)));
typedef unsigned u32x2 __attribute__((ext_vector_type(2)));
typedef __bf16 bf16x2_t __attribute__((ext_vector_type(2)));

__device__ __forceinline__ unsigned cvtpk(float lo, float hi) { f32x2 v = {lo, hi}; bf16x2_t b = __builtin_convertvector(v, bf16x2_t); return __builtin_bit_cast(unsigned, b); }
__device__ __forceinline__ float bf2f(unsigned short u) { return __uint_as_float((unsigned)u << 16); }
__device__ __forceinline__ float wave_sum(float v) {
#pragma unroll
    for (int o = 1; o < 64; o <<= 1) v += __shfl_xor(v, o);
    return v;
}
__device__ __forceinline__ float fexp2(float x) { return __builtin_amdgcn_exp2f(x); }

struct WItem { f32x4 v[8]; float g[8]; };
__device__ __forceinline__ void witem_load(WItem& w, const float* W, int N, const float* gk, int item, int nblk, int lane) {
    const int kb = item / nblk, nb = item % nblk, k0 = 64 * kb, n0 = 32 * nb;
    const int col = 4 * (lane & 7), rr = lane >> 3;
    const bool ok = (n0 + col) < N;
#pragma unroll
    for (int i = 0; i < 8; ++i) { w.v[i] = ok ? __builtin_nontemporal_load((const f32x4*)(W + (size_t)(k0 + 8 * i + rr) * N + n0 + col)) : (f32x4){0.f, 0.f, 0.f, 0.f};
        w.g[i] = gk ? gk[k0 + 8 * i + rr] : 1.f; }
}
__device__ __forceinline__ void witem_store(const WItem& w, int K, bf16_t* WT, int kvperm, LAS float* scr, int item, int nblk, int lane) {
    const int kb = item / nblk, nb = item % nblk, k0 = 64 * kb, n0 = 32 * nb;
    const int col = 4 * (lane & 7), rr = lane >> 3;
#pragma unroll
    for (int i = 0; i < 8; ++i) { LAS float* d = scr + (8 * i + rr) * 33 + col; const float g = w.g[i]; d[0] = w.v[i].x * g; d[1] = w.v[i].y * g; d[2] = w.v[i].z * g; d[3] = w.v[i].w * g; }
    asm volatile("s_waitcnt lgkmcnt(0)" ::: "memory");
    const int c = lane & 7;
#pragma unroll
    for (int j = 0; j < 4; ++j) { const int n = (lane >> 3) + 8 * j; const LAS float* s = scr + (8 * c) * 33 + n;
        u32x4 o; o.x = cvtpk(s[0 * 33], s[1 * 33]); o.y = cvtpk(s[2 * 33], s[3 * 33]); o.z = cvtpk(s[4 * 33], s[5 * 33]); o.w = cvtpk(s[6 * 33], s[7 * 33]);
        int nr = n0 + n; if (kvperm == 1) { const int hh = nr >> 8, ww = nr & 255; nr = (ww < 128) ? hh * 128 + ww : 2048 + hh * 128 + (ww - 128); }
        else if (kvperm == 2) { const int isv = nr >= 5632, f = isv ? nr - 5632 : nr; nr = (f >> 7) * 256 + isv * 128 + (f & 127); }
        *(u32x4*)(WT + (size_t)nr * K + k0 + 8 * c) = o; }
    asm volatile("s_waitcnt lgkmcnt(0)" ::: "memory");
}
struct WaveSlot { int gw, NGW, rot; };
__device__ __forceinline__ void convert_weight(const float* W, int K, int N, int Npad, bf16_t* WT, int kvperm, const float* gk, LAS float* scr, WaveSlot& ws, int lane, int pct0 = 0, int pct1 = 100) {
    const int nblk = Npad / 32, nitems = (K / 64) * nblk;
    const int i0 = (int)((long)nitems * pct0 / 100), i1 = (int)((long)nitems * pct1 / 100);
    const int NGW = ws.NGW;
    int gwr = ws.gw - ws.rot; if (gwr < 0) gwr += NGW;
    ws.rot = (ws.rot + (i1 - i0)) % NGW;
    int it = i0 + gwr;
    WItem cur, nxt;
    if (it < i1) witem_load(nxt, W, N, gk, it, nblk, lane);
    while (it < i1) {
        cur = nxt;
        const int nit = it + NGW;
        if (nit < i1) witem_load(nxt, W, N, gk, nit, nblk, lane);
        witem_store(cur, K, WT, kvperm, scr, it, nblk, lane);
        it = nit;
    }
}

__device__ __forceinline__ void p0_row(const float* xrow, bf16_t* hbrow, float* ss, int lane) {
    f32x4 v[8]; float s = 0.f;
#pragma unroll
    for (int j = 0; j < 8; ++j) { v[j] = *(const f32x4*)(xrow + 4 * lane + 256 * j); s += (v[j].x * v[j].x + v[j].y * v[j].y) + (v[j].z * v[j].z + v[j].w * v[j].w); }
    s = wave_sum(s);
    if (lane < 32) ss[lane] = lane == 0 ? s : 0.f;
#pragma unroll
    for (int j = 0; j < 8; ++j) {
        u32x2 w; w.x = cvtpk(v[j].x, v[j].y); w.y = cvtpk(v[j].z, v[j].w);
        *(u32x2*)(hbrow + 4 * lane + 256 * j) = w; }
}
__device__ __forceinline__ void final_row(const bf16_t* hrow, const float* gain, const float* ssrow, float* orow, int lane) {
    const float ss = wave_sum(lane < 32 ? ssrow[lane] : 0.f);
    const float r = 1.0f / sqrtf(ss * (1.f / D) + EPS);
#pragma unroll
    for (int j = 0; j < 8; ++j) { const u32x2 hw = *(const u32x2*)(hrow + 4 * lane + 256 * j); const f32x4 g = *(const f32x4*)(gain + 4 * lane + 256 * j);
        f32x4 o; o.x = __uint_as_float(hw.x << 16) * r * g.x; o.y = __uint_as_float(hw.x & 0xffff0000u) * r * g.y; o.z = __uint_as_float(hw.y << 16) * r * g.z; o.w = __uint_as_float(hw.y & 0xffff0000u) * r * g.w;
        *(f32x4*)(orow + 4 * lane + 256 * j) = o; }
}

__device__ const double ROPE_INV[32] = {
1.0, 0.7498942093324559, 0.5623413251903491, 0.4216965034285822,
0.31622776601683794, 0.23713737056616552, 0.1778279410038923, 0.1333521432163324,
0.1, 0.07498942093324558, 0.05623413251903491, 0.042169650342858224,
0.03162277660168379, 0.023713737056616554, 0.01778279410038923, 0.01333521432163324,
0.01, 0.007498942093324558, 0.005623413251903491, 0.004216965034285823,
0.0031622776601683794, 0.0023713737056616554, 0.0017782794100389228, 0.001333521432163324,
0.001, 0.0007498942093324559, 0.0005623413251903491, 0.00042169650342858224,
0.00031622776601683794, 0.00023713737056616554, 0.00017782794100389227, 0.0001333521432163324};
__device__ __forceinline__ void rope_cs(int pos, int i, float& c, float& s) {
    double rev = (double)pos * ROPE_INV[i] * 0.15915494309189535;
    rev -= __builtin_rint(rev);
    const float rf = (float)rev;
    s = __builtin_amdgcn_sinf(rf); c = __builtin_amdgcn_cosf(rf);
}

__device__ __forceinline__ s16x4 vtr(const LAS unsigned char* p) {
    typedef short v4i16_t __attribute__((ext_vector_type(4)));
    return __builtin_bit_cast(s16x4, __builtin_amdgcn_ds_read_tr16_b64_v4i16((LAS v4i16_t*)p));
}
template <int DQK, class MB>
__device__ __forceinline__ void tile_qk(const LAS unsigned char* Kt, const bf16x8 (&qf)[DQK / 16], f32x16& s0, f32x16& s1, int lane, const MB& mb) {
    constexpr int KP = DQK * 2 + 16;
    const int r32 = lane & 31, hi = lane >> 5;
#pragma unroll
    for (int r = 0; r < 16; ++r) { s0[r] = 0.f; s1[r] = 0.f; }
    const LAS unsigned char* kp = Kt + r32 * KP + hi * 16;
#pragma unroll
    for (int ks = 0; ks < DQK / 16; ++ks) {
        const bf16x8 k0 = *(const LAS bf16x8*)(kp + ks * 32);
        const bf16x8 k1 = *(const LAS bf16x8*)(kp + 32 * KP + ks * 32);
        s0 = __builtin_amdgcn_mfma_f32_32x32x16_bf16(k0, qf[ks], s0, 0, 0, 0);
        s1 = __builtin_amdgcn_mfma_f32_32x32x16_bf16(k1, qf[ks], s1, 0, 0, 0);
    }
    mb(s0, s1);
}
template <int DV>
__device__ __forceinline__ void tile_pv(const LAS unsigned char* Vt, f32x16& s0, f32x16& s1, f32x16 (&o)[DV / 32], float& m, float& l, int lane) {
    constexpr int VP = DV * 2 + 64;
    const int hi = lane >> 5;
    float mx = s0[0];
#pragma unroll
    for (int r = 0; r < 16; ++r) { mx = fmaxf(mx, s0[r]); mx = fmaxf(mx, s1[r]); }
    mx = fmaxf(mx, __shfl_xor(mx, 32));
    if (__any(mx > m + 4.0f)) {
        const float mnew = fmaxf(m, mx);
        const float alpha = fexp2(m - mnew);
        m = mnew; l *= alpha;
#pragma unroll
        for (int db = 0; db < DV / 32; ++db)
#pragma unroll
            for (int r = 0; r < 16; ++r) o[db][r] *= alpha;
    }
    float ps = 0.f;
#pragma unroll
    for (int r = 0; r < 16; ++r) { s0[r] = fexp2(s0[r] - m); s1[r] = fexp2(s1[r] - m); ps += s0[r] + s1[r]; }
    ps += __shfl_xor(ps, 32);
    l += ps;
    bf16x8 pf[4];
    {
        u32x4 w;
        w.x = cvtpk(s0[0], s0[1]); w.y = cvtpk(s0[2], s0[3]); w.z = cvtpk(s0[4], s0[5]); w.w = cvtpk(s0[6], s0[7]); pf[0] = __builtin_bit_cast(bf16x8, w);
        w.x = cvtpk(s0[8], s0[9]); w.y = cvtpk(s0[10], s0[11]); w.z = cvtpk(s0[12], s0[13]); w.w = cvtpk(s0[14], s0[15]); pf[1] = __builtin_bit_cast(bf16x8, w);
        w.x = cvtpk(s1[0], s1[1]); w.y = cvtpk(s1[2], s1[3]); w.z = cvtpk(s1[4], s1[5]); w.w = cvtpk(s1[6], s1[7]); pf[2] = __builtin_bit_cast(bf16x8, w);
        w.x = cvtpk(s1[8], s1[9]); w.y = cvtpk(s1[10], s1[11]); w.z = cvtpk(s1[12], s1[13]); w.w = cvtpk(s1[14], s1[15]); pf[3] = __builtin_bit_cast(bf16x8, w);
    }
    const LAS unsigned char* vp = Vt + (4 * hi + ((lane & 15) >> 2)) * VP + (16 * ((lane >> 4) & 1) + 4 * (lane & 3)) * 2;
#pragma unroll
    for (int db = 0; db < DV / 32; ++db) {
#pragma unroll
        for (int sp = 0; sp < 4; ++sp) {
            const s16x4 lo = vtr(vp + (16 * sp) * VP + db * 64);
            const s16x4 hh = vtr(vp + (16 * sp + 8) * VP + db * 64);
            const bf16x8 vf = {lo[0], lo[1], lo[2], lo[3], hh[0], hh[1], hh[2], hh[3]};
            o[db] = __builtin_amdgcn_mfma_f32_32x32x16_bf16(vf, pf[sp], o[db], 0, 0, 0);
        }
    }
}
template <int DQK, int DV, class MB>
__device__ __forceinline__ void tile_step(const LAS unsigned char* Kt, const LAS unsigned char* Vt, const bf16x8 (&qf)[DQK / 16], f32x16 (&o)[DV / 32], float& m, float& l, int lane, const MB& mb) {
    f32x16 s0, s1;
    tile_qk<DQK>(Kt, qf, s0, s1, lane, mb);
    tile_pv<DV>(Vt, s0, s1, o, m, l, lane);
}

template <int DQK, bool FOX> struct CausalMB {
    const LAS float* ck; float cq; int qg, kv0, hi; bool need_mask;
    __device__ __forceinline__ void operator()(f32x16& s0, f32x16& s1) const {
        if constexpr (FOX) {
#pragma unroll
            for (int g = 0; g < 4; ++g) {
                const f32x4 c0 = *(const LAS f32x4*)(ck + 8 * g + 4 * hi), c1 = *(const LAS f32x4*)(ck + 32 + 8 * g + 4 * hi);
#pragma unroll
                for (int i = 0; i < 4; ++i) { s0[4 * g + i] -= c0[i]; s1[4 * g + i] -= c1[i]; }
            }
        }
        if (need_mask) {
            const int rel = qg - kv0 - 4 * hi;
#pragma unroll
            for (int r = 0; r < 16; ++r) { const int kvl = (r & 3) + 8 * (r >> 2); if (kvl > rel) s0[r] = -INFINITY; if (kvl + 32 > rel) s1[r] = -INFINITY; }
        }
    }
};

template <int DQK, bool FOX>
__device__ __forceinline__ void causal_attn_phase(LAS unsigned char* lds, const bf16_t* Q, int qpitch, const bf16_t* K1, const bf16_t* K2, const bf16_t* V, bf16_t* O, const float* cum2, const float* rope_cs_tab, const float* fox_ct) {
    constexpr int DV = 128, NKS = DQK / 16, KP = DQK * 2 + 16, VP = DV * 2 + 64;
    constexpr int KT_BYTES = 64 * KP, VT_BYTES = 64 * VP, BUF = KT_BYTES + VT_BYTES + 256;
    constexpr int NCHK = DQK / 8, NK = 64 * NCHK / 512, NV = 2;
    static_assert(2 * BUF + 1024 <= 131072, "lds");
    const int tid = ltid(), lane = tid & 63, wid = __builtin_amdgcn_readfirstlane(tid >> 6), r32 = lane & 31, hi = lane >> 5;
    for (int u = blockIdx.x; u < 512; u += gridDim.x) {
        const int rnd = u >> 8, bb = u & 255, head = bb & 15, qb = rnd == 0 ? 31 - (bb >> 4) : (bb >> 4);
        const int q0 = qb * 256, qrow = q0 + wid * 32 + r32;
        bf16x8 qf[NKS];
        { const bf16_t* qp = Q + (size_t)qrow * qpitch + head * DQK + hi * 8;
#pragma unroll
          for (int ks = 0; ks < NKS; ++ks) qf[ks] = *(const bf16x8*)(qp + ks * 16); }
        if constexpr (DQK == 192) {
#pragma unroll
            for (int sidx = 0; sidx < 2; ++sidx) {
                const f32x4* csp = (const f32x4*)(rope_cs_tab + (size_t)qrow * 64 + (16 * sidx + 8 * hi) * 2);
#pragma unroll
                for (int jj = 0; jj < 4; ++jj) { const f32x4 cs = csp[jj];
#pragma unroll
                    for (int e = 0; e < 2; ++e) { const int j = 2 * jj + e; const float c = e ? cs.z : cs.x, sn = e ? cs.w : cs.y;
                        const float x1 = bf2f((unsigned short)qf[8 + sidx][j]), x2 = bf2f((unsigned short)qf[10 + sidx][j]);
                        qf[8 + sidx][j] = (short)(cvtpk(x1 * c - x2 * sn, 0.f) & 0xffffu); qf[10 + sidx][j] = (short)(cvtpk(x2 * c + x1 * sn, 0.f) & 0xffffu); } }
            }
        }
        LAS float* offs = (LAS float*)(lds + 2 * BUF);
        if constexpr (FOX) {
            if (wid == 0) { const float a = fox_ct[head * 128 + lane], b = fox_ct[head * 128 + 64 + lane]; float ia = a, ib = b;
#pragma unroll
                for (int o_ = 1; o_ < 64; o_ <<= 1) { const float va = __shfl_up(ia, o_), vb = __shfl_up(ib, o_); if (lane >= o_) { ia += va; ib += vb; } }
                const float tota = __shfl(ia, 63);
                offs[lane] = ia - a; offs[64 + lane] = tota + (ib - b);
                float km = fmaxf(fox_ct[T + head * 128 + lane], fox_ct[T + head * 128 + 64 + lane]);
#pragma unroll
                for (int o_ = 1; o_ < 64; o_ <<= 1) km = fmaxf(km, __shfl_xor(km, o_));
                if (lane == 0) { offs[128] = km; offs[132] = 0.f; offs[133] = 0.f; offs[134] = 0.f; offs[135] = 0.f; } }
            __syncthreads();
        }
        const float cq = FOX ? (cum2[head * T + qrow] + offs[qrow >> 6]) * LOG2E : 0.f;
        f32x16 o[4];
#pragma unroll
        for (int db = 0; db < 4; ++db)
#pragma unroll
            for (int r = 0; r < 16; ++r) o[db][r] = 0.f;
        float m = -1e30f, l = 0.f;
        const int NT = (q0 + 256) / 64;
        u32x4 kreg[NK], vreg[NV]; float ckreg = 0.f;
        unsigned koff[NK], voff[NV]; bool krope[NK];
#pragma unroll
        for (int i_ = 0; i_ < NK; ++i_) { const int id_ = tid + 512 * i_, row_ = id_ / NCHK, ch_ = id_ % NCHK; krope[i_] = (DQK == 192 && ch_ >= 16);
            koff[i_] = krope[i_] ? (unsigned)(row_ * 64 + (ch_ - 16) * 8) : (unsigned)(row_ * 2048 + ch_ * 8); }
#pragma unroll
        for (int i_ = 0; i_ < NV; ++i_) { const int id_ = tid + 512 * i_, row_ = id_ >> 4, ch_ = id_ & 15; voff[i_] = (unsigned)(row_ * 2048 + ch_ * 8); }
        const bf16_t* K1h = K1 + head * 128; const bf16_t* Vh = V + head * 128;
#define CA_GLOAD(t) do { const size_t t0_ = (size_t)(t) * 64; const bf16_t* k1b_ = K1h + t0_ * 2048; const bf16_t* k2b_ = K2 + t0_ * 64; const bf16_t* vb_ = Vh + t0_ * 2048; \
            _Pragma("unroll") for (int i_ = 0; i_ < NK; ++i_) kreg[i_] = *(const u32x4*)((krope[i_] ? k2b_ : k1b_) + koff[i_]); \
            _Pragma("unroll") for (int i_ = 0; i_ < NV; ++i_) vreg[i_] = *(const u32x4*)(vb_ + voff[i_]); \
            if (FOX && tid < 64) ckreg = (cum2[head * T + (int)t0_ + tid] + offs[(t)]) * LOG2E; } while (0)
#define CA_LSTORE(b) do { LAS unsigned char* base_ = lds + (b) * BUF; \
            _Pragma("unroll") for (int i_ = 0; i_ < NK; ++i_) { const int id_ = tid + 512 * i_, row_ = id_ / NCHK, ch_ = id_ % NCHK; *(LAS u32x4*)(base_ + row_ * KP + ch_ * 16) = kreg[i_]; } \
            _Pragma("unroll") for (int i_ = 0; i_ < NV; ++i_) { const int id_ = tid + 512 * i_, row_ = id_ >> 4, ch_ = id_ & 15; *(LAS u32x4*)(base_ + KT_BYTES + row_ * VP + ch_ * 16) = vreg[i_]; } \
            if (FOX && tid < 64) *(LAS float*)(base_ + KT_BYTES + VT_BYTES + tid * 4) = ckreg; } while (0)
        if constexpr (!FOX) {
            CA_GLOAD(0); CA_LSTORE(0); __syncthreads();
            for (int t = 0; t < NT; ++t) {
                if (t + 1 < NT) CA_GLOAD(t + 1);
                const int kv0 = t * 64;
                if (kv0 <= q0 + wid * 32 + 31) {
                    const LAS unsigned char* base = lds + (t & 1) * BUF;
                    CausalMB<DQK, FOX> mb; mb.ck = (const LAS float*)(base + KT_BYTES + VT_BYTES); mb.cq = cq; mb.qg = qrow; mb.kv0 = kv0; mb.hi = hi; mb.need_mask = (kv0 + 63 > q0 + wid * 32);
                    tile_step<DQK, DV>(base, base + KT_BYTES, qf, o, m, l, lane, mb);
                }
                if (t + 1 < NT) CA_LSTORE((t + 1) & 1);
                __syncthreads();
            }
        } else {
            float qn = 0.f;
#pragma unroll
            for (int ks = 0; ks < NKS; ++ks)
#pragma unroll
                for (int j = 0; j < 8; ++j) { const float a = bf2f((unsigned short)qf[ks][j]); qn += a * a; }
            qn += __shfl_xor(qn, 32);
            qn = sqrtf(qn) * offs[128] * 1.02f + 1.0f;
            volatile LAS int* dflag = (volatile LAS int*)(offs + 136);
            bool done = false;
            CA_GLOAD(NT - 1); CA_LSTORE(0); __syncthreads();
            for (int tt = 0; tt < NT; ++tt) {
                const int t = NT - 1 - tt;
                if (t > 0) CA_GLOAD(t - 1);
                const int kv0 = t * 64;
                const LAS unsigned char* base = lds + (tt & 1) * BUF;
                const LAS float* ckp = (const LAS float*)(base + KT_BYTES + VT_BYTES);
                if (!done && kv0 <= q0 + wid * 32 + 31) {
                    const float bound = qn - ckp[63];
                    if (__all(bound - m < -150.0f)) done = true;
                    else {
                        CausalMB<DQK, FOX> mb; mb.ck = ckp; mb.cq = cq; mb.qg = qrow; mb.kv0 = kv0; mb.hi = hi; mb.need_mask = (kv0 + 63 > q0 + wid * 32);
                        tile_step<DQK, DV>(base, base + KT_BYTES, qf, o, m, l, lane, mb);
                    }
                }
                if (lane == 0) dflag[(tt & 1) * 8 + wid] = done ? 1 : 0;
                if (t > 0) CA_LSTORE((tt + 1) & 1);
                __syncthreads();
                int alld = 1;
#pragma unroll
                for (int w_ = 0; w_ < 8; ++w_) alld &= dflag[(tt & 1) * 8 + w_];
                if (alld) break;
            }
            __syncthreads();
        }
#undef CA_GLOAD
#undef CA_LSTORE
        const float il = 1.0f / l;
        bf16_t* op = O + (size_t)qrow * 2048 + head * 128 + 4 * hi;
#pragma unroll
        for (int db = 0; db < 4; ++db)
#pragma unroll
            for (int g = 0; g < 4; ++g) { u32x2 w; w.x = cvtpk(o[db][4 * g] * il, o[db][4 * g + 1] * il); w.y = cvtpk(o[db][4 * g + 2] * il, o[db][4 * g + 3] * il);
                *(u32x2*)(op + 32 * db + 8 * g) = w; }
    }
}

__device__ __forceinline__ int t5_bucket(int n) {
    if (n < 16) return n;
    const float nf = (float)n;
    int large = 16 + (int)(logf(nf / 16.f) / logf(128.f) * 16.f);
    return large < 31 ? large : 31;
}
__device__ __forceinline__ void t5_table_phase(const float* rel_bias, float* tab, int gtid, int nthreads) {
    for (int i = gtid; i < 3 * 32 * 132; i += nthreads) {
        const int ri = i / (32 * 132), h = (i / 132) & 31, j = i % 132, rate = ri == 0 ? 1 : (ri == 1 ? 4 : 16);
        tab[i] = (j <= 128) ? rel_bias[t5_bucket(rate * j) * 32 + h] * LOG2E : 0.f;
    }
}
struct BandMB {
    const LAS float* tbx; int qrel, krel0, hi;
    __device__ __forceinline__ void operator()(f32x16& s0, f32x16& s1) const {
        const LAS float* p = tbx + (qrel - krel0 - 4 * hi + 128 - 59);
#pragma unroll
        for (int r = 0; r < 16; ++r) {
            const int kvl = (r & 3) + 8 * (r >> 2);
            s0[r] += p[59 - kvl];
            s1[r] += p[27 - kvl];
        }
    }
};
template <bool SWA>
__device__ __forceinline__ void banded_attn_phase(LAS unsigned char* lds, const bf16_t* Q, const bf16_t* K, const bf16_t* V, int kvpitch, const float* t5tab  , const float* sinks,
                                                  int rate, int max_dist, int mode, float* Acc, float* Mst, float* Lst, bf16_t* O) {
    constexpr int DQK = 64, DV = 64, KP = DQK * 2 + 16, VP = DV * 2 + 64;
    constexpr int KB_BYTES = 128 * KP, VB_BYTES = 128 * VP, HALF_BYTES = KB_BYTES + VB_BYTES + 2048;
    static_assert(2 * HALF_BYTES <= 131072, "lds");
    const int tid = ltid(), lane = tid & 63, wid = __builtin_amdgcn_readfirstlane(tid >> 6), r32 = lane & 31, hi = lane >> 5;
    const int half = wid >> 2, w4 = wid & 3, th = tid & 255;
    LAS unsigned char* hb = lds + half * HALF_BYTES;
    LAS float* tb = (LAS float*)(hb + KB_BYTES + VB_BYTES);
    u32x4 kreg[4], vreg[4];
#define BD_GLOAD(uu, kk) do { const int cb_ = (uu) >> 4, c_ = cb_ % rate, b_ = cb_ / rate, head_ = ((uu) & 15) * 2 + half, kvh_ = SWA ? (head_ >> 3) : head_; const int ks0_ = (b_ - 1 + (kk)) * 128; \
        _Pragma("unroll") for (int i = 0; i < 4; ++i) { const int id = th + 256 * i, row = id >> 3, ch = id & 7; const size_t tok = (size_t)(ks0_ + row) * rate + c_; \
            kreg[i] = *(const u32x4*)(K + tok * kvpitch + kvh_ * 64 + ch * 8); vreg[i] = *(const u32x4*)(V + tok * kvpitch + kvh_ * 64 + ch * 8); } } while (0)
    const float* tabr = t5tab + (rate == 1 ? 0 : (rate == 4 ? 1 : 2)) * (32 * 132);
    bf16x8 qnext[4]; float tbnext = 0.f, tbnext2 = 0.f; float mnext = 0.f, lnext = 0.f; u32x2 onext[2][4];
#define BD_QLOAD(uu) do { const int cb_ = (uu) >> 4, c_ = cb_ % rate, b_ = cb_ / rate, head_ = ((uu) & 15) * 2 + half; const int qtok_ = (b_ * 128 + w4 * 32 + r32) * rate + c_; \
        const bf16_t* qp_ = Q + (size_t)qtok_ * 2048 + head_ * 64 + hi * 8; _Pragma("unroll") for (int ks = 0; ks < 4; ++ks) qnext[ks] = *(const bf16x8*)(qp_ + ks * 16); \
        if (mode == 1 || mode == 2) { mnext = Mst[(size_t)qtok_ * 32 + head_]; lnext = Lst[(size_t)qtok_ * 32 + head_]; const bf16_t* ap_ = O + (size_t)qtok_ * 2048 + head_ * 64 + 4 * hi; \
            _Pragma("unroll") for (int db = 0; db < 2; ++db) _Pragma("unroll") for (int g = 0; g < 4; ++g) onext[db][g] = *(const u32x2*)(ap_ + 32 * db + 8 * g); } \
        { const int d0_ = th - 128, d1_ = th + 128; tbnext = (d0_ >= 0 && d0_ <= max_dist) ? tabr[head_ * 132 + d0_] : -INFINITY; tbnext2 = (th < 128 && d1_ <= max_dist) ? tabr[head_ * 132 + d1_] : -INFINITY; } } while (0)
    if ((int)blockIdx.x < 1024) { const int u0 = blockIdx.x; BD_GLOAD(u0, (((u0 >> 4) / rate) == 0 ? 1 : 0)); BD_QLOAD(u0); }
    for (int u = blockIdx.x; u < 1024; u += gridDim.x) {
        const int hp = u & 15, cb = u >> 4, c = cb % rate, b = cb / rate;
        const int head = hp * 2 + half;
        const int qrel = w4 * 32 + r32, qtok = (b * 128 + qrel) * rate + c;
        bf16x8 qf[4];
#pragma unroll
        for (int ks = 0; ks < 4; ++ks) qf[ks] = qnext[ks];
        if (u == (int)blockIdx.x || (gridDim.x & 15u) != 0u) { tb[th] = tbnext; if (th < 128) tb[256 + th] = tbnext2; }
        f32x16 o[2]; float m, l;
        if (mode == 1 || mode == 2) {
            m = mnext; l = lnext;
#pragma unroll
            for (int db = 0; db < 2; ++db)
#pragma unroll
                for (int g = 0; g < 4; ++g) { const u32x2 v = onext[db][g];
                    o[db][4 * g] = __uint_as_float(v.x << 16) * l; o[db][4 * g + 1] = __uint_as_float(v.x & 0xffff0000u) * l; o[db][4 * g + 2] = __uint_as_float(v.y << 16) * l; o[db][4 * g + 3] = __uint_as_float(v.y & 0xffff0000u) * l; }
        } else {
            m = -1e30f; l = 0.f;
#pragma unroll
            for (int db = 0; db < 2; ++db)
#pragma unroll
                for (int r = 0; r < 16; ++r) o[db][r] = 0.f;
        }
        for (int kb = (b == 0 ? 1 : 0); kb < 2; ++kb) {
#pragma unroll
            for (int i = 0; i < 4; ++i) { const int id = th + 256 * i, row = id >> 3, ch = id & 7;
                *(LAS u32x4*)(hb + row * KP + ch * 16) = kreg[i]; *(LAS u32x4*)(hb + KB_BYTES + row * VP + ch * 16) = vreg[i]; }
            __syncthreads();
            if (kb == 0) BD_GLOAD(u, 1);
            else { const int un = u + (int)gridDim.x; if (un < 1024) { BD_GLOAD(un, (((un >> 4) / rate) == 0 ? 1 : 0)); BD_QLOAD(un); } }
            for (int tile = 0; tile < 2; ++tile) {
                const int krel0 = (kb - 1) * 128 + tile * 64;
                const int dmin = w4 * 32 - (krel0 + 63), dmax = w4 * 32 + 31 - krel0;
                if (dmax < 0 || dmin > max_dist) continue;
                BandMB mb; mb.tbx = tb; mb.qrel = qrel; mb.krel0 = krel0; mb.hi = hi;
                tile_step<DQK, DV>(hb + tile * 64 * KP, hb + KB_BYTES + tile * 64 * VP, qf, o, m, l, lane, mb);
            }
            __syncthreads();
        }
#undef BD_GLOAD
#undef BD_QLOAD
        if (mode == 0 || mode == 1) {
            if (hi == 0) { Mst[(size_t)qtok * 32 + head] = m; Lst[(size_t)qtok * 32 + head] = l; }
            const float sc = 1.0f / l;
            bf16_t* op = O + (size_t)qtok * 2048 + head * 64 + 4 * hi;
#pragma unroll
            for (int db = 0; db < 2; ++db)
#pragma unroll
                for (int g = 0; g < 4; ++g) { u32x2 w; w.x = cvtpk(o[db][4 * g] * sc, o[db][4 * g + 1] * sc); w.y = cvtpk(o[db][4 * g + 2] * sc, o[db][4 * g + 3] * sc);
                    *(u32x2*)(op + 32 * db + 8 * g) = w; }
        } else {
            float sc;
            if (mode == 3) { const float sk = sinks[head] * LOG2E; const float m2 = fmaxf(m, sk); const float a = fexp2(m - m2); sc = a / (l * a + fexp2(sk - m2)); }
            else sc = 1.0f / l;
            bf16_t* op = O + (size_t)qtok * 2048 + head * 64 + 4 * hi;
#pragma unroll
            for (int db = 0; db < 2; ++db)
#pragma unroll
                for (int g = 0; g < 4; ++g) { u32x2 w; w.x = cvtpk(o[db][4 * g] * sc, o[db][4 * g + 1] * sc); w.y = cvtpk(o[db][4 * g + 2] * sc, o[db][4 * g + 3] * sc);
                    *(u32x2*)(op + 32 * db + 8 * g) = w; }
        }
    }
}

__device__ __forceinline__ void mla_krope_phase(const bf16_t* LATR, const int* pos, bf16_t* KR, float* CS, int gw, int NGW, int lane) {
    for (int r2 = gw; r2 < T / 2; r2 += NGW) {
        const int row = 2 * r2 + (lane >> 5), i = lane & 31;
        float c, s; rope_cs(pos[row], i, c, s);
        *(f32x2*)(CS + (size_t)row * 64 + 2 * i) = (f32x2){c, s};
        const float x1 = bf2f(LATR[(size_t)row * 512 + i]), x2 = bf2f(LATR[(size_t)row * 512 + 32 + i]);
        const unsigned a = cvtpk(x1 * c - x2 * s, 0.f), bq = cvtpk(x2 * c + x1 * s, 0.f);
        KR[(size_t)row * 64 + i] = (bf16_t)(a & 0xffffu); KR[(size_t)row * 64 + 32 + i] = (bf16_t)(bq & 0xffffu);
    }
}
__device__ __forceinline__ void fox_scan_phase(const bf16_t* GATE  , const float* b_f, float* LPRE, float* CT, const bf16_t* Kb  , float* KMAX, int gw, int NGW, int lane) {
    for (int task = gw; task < 2048; task += NGW) {
        const int c = task >> 4, h = task & 15, t = c * 64 + lane;
        const float x = bf2f(GATE[(size_t)t * 2048 + h]) + b_f[h];
        float inc = fminf(x, 0.f) - log1pf(expf(-fabsf(x)));
#pragma unroll
        for (int o = 1; o < 64; o <<= 1) { const float v = __shfl_up(inc, o); if (lane >= o) inc += v; }
        LPRE[(size_t)h * T + t] = inc;
        if (lane == 63) CT[h * 128 + c] = inc;
        const u32x4* kp = (const u32x4*)(Kb + (size_t)t * 2048 + h * 128);
        float ss = 0.f;
#pragma unroll
        for (int i = 0; i < 16; ++i) { const u32x4 w = kp[i];
#pragma unroll
            for (int e = 0; e < 4; ++e) { const float a = __uint_as_float(w[e] << 16), b = __uint_as_float(w[e] & 0xffff0000u); ss += a * a + b * b; } }
        float nm = sqrtf(ss);
#pragma unroll
        for (int o = 1; o < 64; o <<= 1) nm = fmaxf(nm, __shfl_xor(nm, o));
        if (lane == 0) KMAX[h * 128 + c] = nm;
    }
}
__device__ __forceinline__ void conv_gate_phase(const bf16_t* U, const float* cw, const float* cb, bf16_t* G) {
    constexpr int TCH = 16, NF8 = DFF / 8, NITEMS = (T / TCH) * NF8;
    for (int it = blockIdx.x * 512 + ltid(); it < NITEMS; it += gridDim.x * 512) {
        const int f8 = it % NF8, tc = it / NF8, f0 = f8 * 8, t0 = tc * TCH;
        float wg[3][8], wv[3][8], bg[8], bv[8];
#pragma unroll
        for (int j = 0; j < 3; ++j)
#pragma unroll
            for (int e = 0; e < 8; ++e) { wg[j][e] = cw[(size_t)j * 2 * DFF + f0 + e]; wv[j][e] = cw[(size_t)j * 2 * DFF + DFF + f0 + e]; }
#pragma unroll
        for (int e = 0; e < 8; ++e) { bg[e] = cb[f0 + e]; bv[e] = cb[DFF + f0 + e]; }
        float g2[8], g1[8], v2[8], v1[8];
#pragma unroll
        for (int e = 0; e < 8; ++e) { g2[e] = g1[e] = v2[e] = v1[e] = 0.f; }
        if (t0 >= 2) {
            const u32x4 a = *(const u32x4*)(U + (size_t)(t0 - 2) * (2 * DFF) + f0), b = *(const u32x4*)(U + (size_t)(t0 - 2) * (2 * DFF) + DFF + f0);
            const u32x4 c = *(const u32x4*)(U + (size_t)(t0 - 1) * (2 * DFF) + f0), d = *(const u32x4*)(U + (size_t)(t0 - 1) * (2 * DFF) + DFF + f0);
#pragma unroll
            for (int e = 0; e < 4; ++e) { g2[2 * e] = __uint_as_float(a[e] << 16); g2[2 * e + 1] = __uint_as_float(a[e] & 0xffff0000u); v2[2 * e] = __uint_as_float(b[e] << 16); v2[2 * e + 1] = __uint_as_float(b[e] & 0xffff0000u);
                g1[2 * e] = __uint_as_float(c[e] << 16); g1[2 * e + 1] = __uint_as_float(c[e] & 0xffff0000u); v1[2 * e] = __uint_as_float(d[e] << 16); v1[2 * e + 1] = __uint_as_float(d[e] & 0xffff0000u); }
        }
#pragma unroll 4
        for (int tt = 0; tt < TCH; ++tt) {
            const int t = t0 + tt;
            const u32x4 a = *(const u32x4*)(U + (size_t)t * (2 * DFF) + f0), b = *(const u32x4*)(U + (size_t)t * (2 * DFF) + DFF + f0);
            float g0[8], v0[8], res[8];
#pragma unroll
            for (int e = 0; e < 4; ++e) { g0[2 * e] = __uint_as_float(a[e] << 16); g0[2 * e + 1] = __uint_as_float(a[e] & 0xffff0000u); v0[2 * e] = __uint_as_float(b[e] << 16); v0[2 * e + 1] = __uint_as_float(b[e] & 0xffff0000u); }
#pragma unroll
            for (int e = 0; e < 8; ++e) {
                const float cg_ = bg[e] + g2[e] * wg[0][e] + g1[e] * wg[1][e] + g0[e] * wg[2][e];
                const float cv_ = bv[e] + v2[e] * wv[0][e] + v1[e] * wv[1][e] + v0[e] * wv[2][e];
                res[e] = cg_ / (1.0f + __expf(-cg_)) * cv_;
                g2[e] = g1[e]; g1[e] = g0[e]; v2[e] = v1[e]; v1[e] = v0[e];
            }
            u32x4 w; w.x = cvtpk(res[0], res[1]); w.y = cvtpk(res[2], res[3]); w.z = cvtpk(res[4], res[5]); w.w = cvtpk(res[6], res[7]);
            *(u32x4*)(G + (size_t)t * DFF + f0) = w;
        }
    }
}

#define XB_TMO      128
#define XB_XCNT(j)  (256  + 64 * (j))
#define XB_XSUB(j)  (1280 + 64 * (j))
#define XB_XGEN(j)  (2304 + 64 * (j))
#define XB_TOP      3328
#define XB_TOPGEN   3392
#define XCD_BAR_WORDS 3456
#define XB_SPIN_CAP (1u << 18)
__device__ __forceinline__ unsigned xb_ld(unsigned* p)              { return __hip_atomic_load(p, __ATOMIC_RELAXED, __HIP_MEMORY_SCOPE_AGENT); }
__device__ __forceinline__ unsigned xb_add(unsigned* p, unsigned v) { return __hip_atomic_fetch_add(p, v, __ATOMIC_RELAXED, __HIP_MEMORY_SCOPE_AGENT); }
__device__ __forceinline__ unsigned xb_xcc_id() { return (unsigned)__builtin_amdgcn_s_getreg((3 << 11) | 20) & 0xFu; }
#define XB_SPIN(cond, bar) do { unsigned _sp = 0; while (cond) { __builtin_amdgcn_s_sleep(1); \
    if ((++_sp & 255u) == 0u) { if (xb_ld(&(bar)[XB_TMO])) break; if (_sp > XB_SPIN_CAP) { atomicAdd(&(bar)[XB_TMO], 1u); break; } } } } while (0)
struct XcdBarrier { unsigned* bar; unsigned x; volatile LAS unsigned* st; };
__device__ __forceinline__ XcdBarrier xcd_barrier_post(unsigned* bar, volatile LAS unsigned* st) {
    XcdBarrier b; b.bar = bar; b.x = xb_xcc_id(); b.st = st;
    if (threadIdx.x == 0) (void)xb_add(&bar[XB_XCNT(b.x)], 1u);
    return b;
}
__device__ __forceinline__ void xcd_barrier_complete(unsigned* bar, unsigned x, unsigned& nloc, unsigned& nx) {
    const unsigned G = gridDim.x * gridDim.y * gridDim.z;
    unsigned sum, cnt, mine, sp = 0u;
    for (;;) {
        sum = 0u; cnt = 0u; mine = 0u;
#pragma unroll
        for (unsigned j = 0; j < 16; ++j) { const unsigned c = xb_ld(&bar[XB_XCNT(j)]); sum += c; cnt += (c > 0u) ? 1u : 0u; mine = (j == x) ? c : mine; }
        if (sum == G) break;
        __builtin_amdgcn_s_sleep(1);
        if ((++sp & 255u) == 0u) { if (xb_ld(&bar[XB_TMO])) break; if (sp > XB_SPIN_CAP) { atomicAdd(&bar[XB_TMO], 1u); break; } }
    }
    nloc = mine > 0u ? mine : 1u; nx = cnt > 0u ? cnt : 1u;
}
__device__ __forceinline__ void xcd_barrier(const XcdBarrier& b) {
    asm volatile("s_waitcnt vmcnt(0)" ::: "memory");
    __syncthreads();
    if (threadIdx.x == 0) {
        unsigned* bar = b.bar;
        __builtin_amdgcn_s_waitcnt(0);
        unsigned nloc = b.st[0], nx = b.st[1];
        if (nloc == 0u) { xcd_barrier_complete(bar, b.x, nloc, nx); b.st[0] = nloc; b.st[1] = nx; }
        const unsigned old = xb_add(&bar[XB_XSUB(b.x)], 1u);
        const unsigned gen = old / nloc;
        if (old + 1u == (gen + 1u) * nloc) {
            __builtin_amdgcn_fence(__ATOMIC_RELEASE, "agent");
            asm volatile("s_waitcnt vmcnt(0)" ::: "memory");
            const unsigned og = xb_add(&bar[XB_TOP], 1u);
            const unsigned tg = og / nx;
            if (og + 1u == (tg + 1u) * nx) xb_add(&bar[XB_TOPGEN], 1u);
            else XB_SPIN(xb_ld(&bar[XB_TOPGEN]) == tg, bar);
            __builtin_amdgcn_fence(__ATOMIC_ACQUIRE, "agent");
            xb_add(&bar[XB_XGEN(b.x)], 1u);
            asm volatile("s_waitcnt vmcnt(0)" ::: "memory");
        } else {
            XB_SPIN(xb_ld(&bar[XB_XGEN(b.x)]) == gen, bar);
            __builtin_amdgcn_fence(__ATOMIC_ACQUIRE, "agent");
            asm volatile("s_waitcnt vmcnt(0)" ::: "memory");
        }
    }
    __syncthreads();
}

typedef const __attribute__((address_space(4))) Params* KParams;
__device__ __forceinline__ KParams kparams() {
    KParams k = (KParams)__builtin_amdgcn_kernarg_segment_ptr();
    asm volatile("" : "+s"(k));
    return k;
}
#define WSP(T_, off) ((T_*)(P->ws + (off)))
constexpr size_t SPLIT = QKV_STRIDE / 2;
#define GEMM_BF16(Aptr, Bptr, N_, K_, Optr, ldc_, bias_, splitc_, scale_, rss_, rinv_, nf4_) do { \
        pg8::Gemm g_{Aptr, Bptr, T, N_, K_, 0}; pg8::StaticOrder S_; S_.init(T, N_, (int)gridDim.x, (int)blockIdx.x); \
        pg8::EpiBf16 E_{Optr, ldc_, bias_, splitc_, SPLIT, scale_, rss_, rinv_, nf4_}; \
        pg8::gemm_phase<pg8::EpiBf16, pg8::StaticOrder, true, true>(lds, g_, S_, E_); } while (0)
#define GEMM_RES(Aptr, Bptr, K_, bias_, ssout_, accs_) do { \
        pg8::Gemm g_{Aptr, Bptr, T, 2048, K_, 0}; pg8::StaticOrder S_; S_.init(T, 2048, (int)gridDim.x, (int)blockIdx.x); \
        pg8::EpiRes E_{WSP(bf16_t, WS_XN), 2048, bias_, ssout_, accs_}; \
        pg8::gemm_phase<pg8::EpiRes, pg8::StaticOrder, true, true>(lds, g_, S_, E_); } while (0)
#define SSP(k) (WSP(float, WS_SS) + (size_t)(k) * T * 32)
#define IDS const int tid = ltid(), lane = tid & 63, wid = __builtin_amdgcn_readfirstlane(tid >> 6); const int gw = blockIdx.x * 8 + wid, NGW = gridDim.x * 8; (void)lane; (void)gw; (void)NGW

#ifdef PROBE_SYNC
#define GSYNC() do { xcd_barrier(xbar); xcd_barrier(xbar); } while (0)
#else
#define GSYNC() xcd_barrier(xbar)
#endif
#define FFN_IN_GEMM(layer) { KParams P = kparams(); \
        pg8::Gemm g_{WSP(bf16_t, WS_XN), WSP(bf16_t, WS_W_FFN_IN + (size_t)(layer) * 44 * MiB), 34 * 256, 11264, 2048, 1}; pg8::StaticOrder S_; S_.init(34 * 256, 11264, (int)gridDim.x, (int)blockIdx.x); \
        pg8::EpiConv E_{WSP(bf16_t, WS_G), P->ffn_conv_w + (size_t)(layer) * 3 * 11264, P->ffn_conv_b + (size_t)(layer) * 11264, SSP(2 * (layer) + 1)}; \
        pg8::gemm_phase<pg8::EpiConv, pg8::StaticOrder, true, true>(lds, g_, S_, E_); }
#define CONV_PHASE(layer) { KParams P = kparams(); conv_gate_phase(WSP(bf16_t, WS_U), P->ffn_conv_w + (size_t)(layer) * 3 * 11264, P->ffn_conv_b + (size_t)(layer) * 11264, WSP(bf16_t, WS_G)); }
#ifdef PROBE_RES
#define PROBE_RES_X(x) x
#else
#define PROBE_RES_X(x)
#endif
#ifdef PROBE_RES2
#define PROBE_RES2_X(x) x
#else
#define PROBE_RES2_X(x)
#endif
#ifdef PROBE_FFN
#define PROBE_FFN_X(layer) __syncthreads(); FFN_IN_GEMM(layer)
#else
#define PROBE_FFN_X(layer)
#endif
#ifdef PROBE_CONV
#define PROBE_CONV_X(layer) CONV_PHASE(layer)
#else
#define PROBE_CONV_X(layer)
#endif

#define SIDE_BEGIN(first_, nb_) { IDS; KParams P = kparams(); const int sf_ = (int)(((long)(first_) * (long)gridDim.x) / 256), snb_ = (int)gridDim.x - sf_; const int sb_ = (int)blockIdx.x - sf_; if (sb_ >= 0) { LAS float* scr = (LAS float*)(lds + wid * 16384); WaveSlot wslot{sb_ * 8 + wid, snb_ * 8, 0};
#define SIDE_END } }
#define CONV_FFN_IN(i, p0_, p1_) convert_weight(P->ffn_w_in + (size_t)(i) * 2048 * 11264, 2048, 11264, 11264, WSP(bf16_t, WS_W_FFN_IN + (size_t)(i) * 44 * MiB), 2, P->norm_ffn + (size_t)(i) * D, scr, wslot, lane, p0_, p1_)
#define CONV_FFN_OUT(i) convert_weight(P->ffn_w_out + (size_t)(i) * 5632 * 2048, 5632, 2048, 2048, WSP(bf16_t, WS_W_FFN_OUT + (size_t)(i) * 22 * MiB), 0, nullptr, scr, wslot, lane)
__global__ void __launch_bounds__(512) mega_fwd(Params p_unused) {
    extern __shared__ __attribute__((aligned(16))) unsigned char lds_raw[];
    LAS unsigned char* lds = (LAS unsigned char*)lds_raw;
    cg::grid_group grid = cg::this_grid();
    { LAS unsigned* misc = (LAS unsigned*)(lds + 131072); if (threadIdx.x < 64) misc[threadIdx.x] = 0u; }
    __syncthreads();
    XcdBarrier xbar;
    { KParams P = kparams(); xbar = xcd_barrier_post((unsigned*)(P->ws + WS_CTL), (volatile LAS unsigned*)(lds + 131072 + 32)); }

#define P0_BODY { \
        IDS; KParams P = kparams(); \
        LAS float* scr = (LAS float*)(lds + wid * 16384); WaveSlot wslot{gw, NGW, 0}; \
        convert_weight(P->mla_w_in, 2048, 1088, 1280, WSP(bf16_t, WS_W_MLA_IN), 0, P->norm_mix, scr, wslot, lane); \
        convert_weight(P->mla_w_qb, 512, 3072, 3072, WSP(bf16_t, WS_W_MLA_QB), 0, P->mla_g_q, scr, wslot, lane); \
        convert_weight(P->mla_w_kvb, 512, 4096, 4096, WSP(bf16_t, WS_W_MLA_KVB), 1, P->mla_g_kv, scr, wslot, lane); \
        convert_weight(P->mla_w_o, 2048, 2048, 2048, WSP(bf16_t, WS_W_MLA_O), 0, nullptr, scr, wslot, lane); \
        convert_weight(P->fox_w_in, 2048, 6160, 6400, WSP(bf16_t, WS_W_FOX_IN), 0, P->norm_mix + 3 * D, scr, wslot, lane); \
        CONV_FFN_IN(0, 0, 100); CONV_FFN_OUT(0); CONV_FFN_OUT(2); CONV_FFN_IN(2, 0, 60); \
        t5_table_phase(P->rel_bias, WSP(float, WS_CQ + 4 * MiB), gw * 64 + lane, NGW * 64); \
        const float* x = P->x; bf16_t* HB = WSP(bf16_t, WS_XN); float* ss0 = SSP(0); \
        for (int row = gw; row < T; row += NGW) p0_row(x + (size_t)row * D, HB + (size_t)row * D, ss0 + (size_t)row * 32, lane); \
    }
    P0_BODY
#ifdef PROBE_P0
    P0_BODY
#endif
    if (gridDim.y == 0xFFFFu) grid.sync();
    GSYNC();

#define LAYER_TAIL(layer, woff, HAS_BO) do { \
        GSYNC(); \
        { KParams P = kparams(); GEMM_RES(WSP(bf16_t, WS_O), WSP(bf16_t, woff), 2048, (HAS_BO ? P->swa_b_o : (const float*)nullptr), SSP(2 * (layer) + 1), 1.f); } \
        PROBE_RES_X({ KParams P = kparams(); GEMM_RES(WSP(bf16_t, WS_O), WSP(bf16_t, woff), 2048, (HAS_BO ? P->swa_b_o : (const float*)nullptr), SSP(2 * (layer) + 1), 0.f); }) \
        GSYNC(); \
        FFN_IN_GEMM(layer) \
        if ((layer) < 3) { SIDE_BEGIN(216, 40) CONV_FFN_IN((layer) + 1, ((layer) == 0 ? 35 : ((layer) == 1 ? 60 : 0)), ((layer) == 0 ? 65 : ((layer) == 1 ? 90 : 30))); SIDE_END } \
        PROBE_FFN_X(layer) \
        GSYNC(); \
        { KParams P = kparams(); GEMM_RES(WSP(bf16_t, WS_G), WSP(bf16_t, WS_W_FFN_OUT + (size_t)(layer) * 22 * MiB), 5632, (const float*)nullptr, SSP(2 * (layer) + 2), 1.f); } \
        PROBE_RES2_X({ KParams P = kparams(); GEMM_RES(WSP(bf16_t, WS_G), WSP(bf16_t, WS_W_FFN_OUT + (size_t)(layer) * 22 * MiB), 5632, (const float*)nullptr, SSP(2 * (layer) + 2), 0.f); }) \
        GSYNC(); \
    } while (0)

    { KParams P = kparams();
      pg8::Gemm g_{WSP(bf16_t, WS_XN), WSP(bf16_t, WS_W_MLA_IN), T, 1280, 2048, 0}; pg8::StaticOrder S_; S_.init(T, 1280, (int)gridDim.x, (int)blockIdx.x);
      pg8::EpiF32<false> E_{nullptr, 512, nullptr, WSP(bf16_t, WS_LAT), SSP(9), SSP(0), (size_t)(8 * MiB / 2), 1.f};
      pg8::gemm_phase<pg8::EpiF32<false>, pg8::StaticOrder, true, true>(lds, g_, S_, E_); }
    SIDE_BEGIN(160, 96)
        convert_weight(P->swa_w_qkv, 2048, 2560, 2560, WSP(bf16_t, WS_W_SWA_QKV), 0, P->norm_mix + D, scr, wslot, lane);
        convert_weight(P->swa_w_o, 2048, 2048, 2048, WSP(bf16_t, WS_W_SWA_O), 0, nullptr, scr, wslot, lane);
        CONV_FFN_IN(1, 0, 35);
    SIDE_END
    GSYNC();
    { KParams P = kparams(); GEMM_BF16(WSP(bf16_t, WS_LAT), WSP(bf16_t, WS_W_MLA_QB), 3072, 512, WSP(bf16_t, WS_Q), 3072, nullptr, 0, 0.07216878364870323f * LOG2E, SSP(9), 1.f / 512.f, 2); }
    { KParams P = kparams(); GEMM_BF16(WSP(bf16_t, WS_LAT + 8 * MiB), WSP(bf16_t, WS_W_MLA_KVB), 4096, 512, WSP(bf16_t, WS_Q + QKV_STRIDE), 2048, nullptr, 2048, 1.0f, SSP(10), 1.f / 512.f, 2); }
    { IDS; KParams P = kparams(); mla_krope_phase(WSP(bf16_t, WS_LAT + 16 * MiB), P->pos, WSP(bf16_t, WS_KROPE), WSP(float, WS_CQ), gw, NGW, lane); }
    SIDE_BEGIN(128, 128)
        convert_weight(P->dil_w_o, 2048, 2048, 2048, WSP(bf16_t, WS_W_DIL_O), 0, nullptr, scr, wslot, lane);
    SIDE_END
    GSYNC();
#define MLA_ATTN { KParams P = kparams(); causal_attn_phase<192, false>(lds, WSP(bf16_t, WS_Q), 3072, WSP(bf16_t, WS_Q + QKV_STRIDE), WSP(bf16_t, WS_KROPE), WSP(bf16_t, WS_Q + 2 * QKV_STRIDE), WSP(bf16_t, WS_O), nullptr, WSP(float, WS_CQ), nullptr); }
    MLA_ATTN
#ifdef PROBE_ATTN
    MLA_ATTN
#endif
    LAYER_TAIL(0, WS_W_MLA_O, false);

    { KParams P = kparams(); GEMM_BF16(WSP(bf16_t, WS_XN), WSP(bf16_t, WS_W_SWA_QKV), 2560, 2048, WSP(bf16_t, WS_Q), 2048, P->swa_b_qkv, 2048, 0.125f * LOG2E, SSP(2), 1.f / 2048.f, 8); }
    SIDE_BEGIN(64, 192)
        CONV_FFN_OUT(1);
        convert_weight(P->dil_w_qkv, 2048, 6144, 6144, WSP(bf16_t, WS_W_DIL_QKV), 0, P->norm_mix + 2 * D, scr, wslot, lane);
        CONV_FFN_IN(1, 65, 100);
        CONV_FFN_IN(2, 90, 100);
    SIDE_END
    GSYNC();
#define SWA_ATTN { KParams P = kparams(); banded_attn_phase<true>(lds, WSP(bf16_t, WS_Q), WSP(bf16_t, WS_Q + QKV_STRIDE), WSP(bf16_t, WS_Q + QKV_STRIDE) + 256, 2048, WSP(float, WS_CQ + 4 * MiB), P->swa_sinks, 1, 127, 3, nullptr, nullptr, nullptr, WSP(bf16_t, WS_O)); }
    SWA_ATTN
#ifdef PROBE_SWA
    SWA_ATTN
#endif
    LAYER_TAIL(1, WS_W_SWA_O, true);

    { KParams P = kparams(); GEMM_BF16(WSP(bf16_t, WS_XN), WSP(bf16_t, WS_W_DIL_QKV), 6144, 2048, WSP(bf16_t, WS_Q), 2048, nullptr, 2048, 0.125f * LOG2E, SSP(4), 1.f / 2048.f, 8); }
    for (int br = 0; br < 3; ++br) {
        GSYNC();
        KParams P = kparams();
        banded_attn_phase<false>(lds, WSP(bf16_t, WS_Q), WSP(bf16_t, WS_Q + QKV_STRIDE), WSP(bf16_t, WS_Q + 2 * QKV_STRIDE), 2048, WSP(float, WS_CQ + 4 * MiB), nullptr, br == 0 ? 1 : (br == 1 ? 4 : 16), 128, br,
                                 WSP(float, WS_ACC), WSP(float, WS_MST), WSP(float, WS_LST), WSP(bf16_t, WS_O));
    }
#ifdef PROBE_DIL
    for (int br = 0; br < 3; ++br) {
        GSYNC();
        KParams P = kparams();
        banded_attn_phase<false>(lds, WSP(bf16_t, WS_Q), WSP(bf16_t, WS_Q + QKV_STRIDE), WSP(bf16_t, WS_Q + 2 * QKV_STRIDE), 2048, WSP(float, WS_CQ + 4 * MiB), nullptr, br == 0 ? 1 : (br == 1 ? 4 : 16), 128, br,
                                 WSP(float, WS_ACC), WSP(float, WS_MST), WSP(float, WS_LST), WSP(bf16_t, WS_O));
    }
#endif
    LAYER_TAIL(2, WS_W_DIL_O, false);

    { KParams P = kparams(); GEMM_BF16(WSP(bf16_t, WS_XN), WSP(bf16_t, WS_W_FOX_IN), 6400, 2048, WSP(bf16_t, WS_Q), 2048, nullptr, 2048, 0.08838834764831845f * LOG2E, SSP(6), 1.f / 2048.f, 8); }
    SIDE_BEGIN(32, 224)
        CONV_FFN_OUT(3);
        convert_weight(P->fox_w_o, 2048, 2048, 2048, WSP(bf16_t, WS_W_FOX_O), 0, nullptr, scr, wslot, lane);
        CONV_FFN_IN(3, 30, 100);
    SIDE_END
    GSYNC();
    { IDS; KParams P = kparams(); fox_scan_phase(WSP(bf16_t, WS_Q + 3 * QKV_STRIDE), P->fox_b_f, WSP(float, WS_CUM), WSP(float, WS_CUM) + 16 * T, WSP(bf16_t, WS_Q + QKV_STRIDE), WSP(float, WS_CUM) + 17 * T, gw, NGW, lane); }
#ifdef PROBE_SCAN
    { IDS; KParams P = kparams(); fox_scan_phase(WSP(bf16_t, WS_Q + 3 * QKV_STRIDE), P->fox_b_f, WSP(float, WS_CUM), WSP(float, WS_CUM) + 16 * T, WSP(bf16_t, WS_Q + QKV_STRIDE), WSP(float, WS_CUM) + 17 * T, gw, NGW, lane); }
#endif
    GSYNC();
#define FOX_ATTN { KParams P = kparams(); causal_attn_phase<128, true>(lds, WSP(bf16_t, WS_Q), 2048, WSP(bf16_t, WS_Q + QKV_STRIDE), nullptr, WSP(bf16_t, WS_Q + 2 * QKV_STRIDE), WSP(bf16_t, WS_O), WSP(float, WS_CUM), nullptr, WSP(float, WS_CUM) + 16 * T); }
    FOX_ATTN
#ifdef PROBE_ATTN
    FOX_ATTN
#endif
    LAYER_TAIL(3, WS_W_FOX_O, false);

    { IDS; KParams P = kparams(); const bf16_t* H = WSP(bf16_t, WS_XN); const float* fn = P->final_norm; float* out = P->out; const float* ss = SSP(8);
      for (int row = gw; row < T; row += NGW) final_row(H + (size_t)row * D, fn, ss + (size_t)row * 32, out + (size_t)row * D, lane); }
}

extern "C" void kernel_launch(void* const* d_in, const int* in_sizes, int n_in, void* d_out, int out_size, void* d_ws, size_t ws_size, hipStream_t stream) {
    static int grid = 0;
    if (grid == 0) {
        if (n_in != 26 || out_size != T * D || ws_size < WS_END) { fprintf(stderr, "kernel_launch: unexpected shapes: n_in %d out %d ws %zu (need %zu)\n", n_in, out_size, ws_size, (size_t)WS_END); grid = -1; return; }
        int dev = 0, cus = 0, per_cu = 0;
        (void)hipGetDevice(&dev);
        (void)hipDeviceGetAttribute(&cus, hipDeviceAttributeMultiprocessorCount, dev);
        if (hipFuncSetAttribute((const void*)mega_fwd, hipFuncAttributeMaxDynamicSharedMemorySize, LDS_BYTES) != hipSuccess) { fprintf(stderr, "kernel_launch: hipFuncSetAttribute failed\n"); grid = -1; return; }
        if (hipOccupancyMaxActiveBlocksPerMultiprocessor(&per_cu, (const void*)mega_fwd, 512, LDS_BYTES) != hipSuccess || per_cu < 1) { fprintf(stderr, "kernel_launch: occupancy query says %d\n", per_cu); per_cu = 1; }
        (void)hipGetLastError();
        grid = cus;
    }
    if (grid < 0) return;
    if (hipMemsetAsync((char*)d_ws + WS_CTL, 0, CTL_BYTES, stream) != hipSuccess) { fprintf(stderr, "kernel_launch: memset failed\n"); return; }
    Params p{};
    p.x = (const float*)d_in[0]; p.pos = (const int*)d_in[1]; p.rel_bias = (const float*)d_in[2]; p.norm_mix = (const float*)d_in[3]; p.norm_ffn = (const float*)d_in[4];
    p.mla_w_in = (const float*)d_in[5]; p.mla_g_q = (const float*)d_in[6]; p.mla_g_kv = (const float*)d_in[7]; p.mla_w_qb = (const float*)d_in[8]; p.mla_w_kvb = (const float*)d_in[9]; p.mla_w_o = (const float*)d_in[10];
    p.swa_w_qkv = (const float*)d_in[11]; p.swa_b_qkv = (const float*)d_in[12]; p.swa_sinks = (const float*)d_in[13]; p.swa_w_o = (const float*)d_in[14]; p.swa_b_o = (const float*)d_in[15];
    p.dil_w_qkv = (const float*)d_in[16]; p.dil_w_o = (const float*)d_in[17];
    p.fox_w_in = (const float*)d_in[18]; p.fox_b_f = (const float*)d_in[19]; p.fox_w_o = (const float*)d_in[20];
    p.ffn_w_in = (const float*)d_in[21]; p.ffn_conv_w = (const float*)d_in[22]; p.ffn_conv_b = (const float*)d_in[23]; p.ffn_w_out = (const float*)d_in[24];
    p.final_norm = (const float*)d_in[25];
    p.out = (float*)d_out; p.ws = (unsigned char*)d_ws;
    void* args[] = {&p};
    hipError_t e = hipLaunchCooperativeKernel((const void*)mega_fwd, dim3(grid), dim3(512), args, LDS_BYTES, stream);
    if (e != hipSuccess) fprintf(stderr, "cooperative launch failed: %s (grid %d)\n", hipGetErrorString(e), grid);
}
```
